# Optimizing an MI355X kernel written in HIP

```python
import jax, jax.numpy as jnp
from jax import lax
import numpy as np

D_MODEL = 2048
BATCH = 4
SEQ = 4096
DEPTH = 2

CHUNK = 64
Q_BLOCK = 128
SB_HEAD_DIM = 128
SB_WIDTH = D_MODEL // 4
SB_HEADS = SB_WIDTH // SB_HEAD_DIM
FOX_HEAD_DIM = 128
FOX_WIDTH = D_MODEL // 4
FOX_HEADS = FOX_WIDTH // FOX_HEAD_DIM
RWKV_HEAD_DIM = 64
RWKV_WIDTH = D_MODEL // 2
RWKV_HEADS = RWKV_WIDTH // RWKV_HEAD_DIM
DECAY_LORA = 64
AAA_LORA = 64
GATE_LORA = 160
RWKV_IN = 3 * RWKV_WIDTH + DECAY_LORA + AAA_LORA + GATE_LORA
N_BRANCHES = 3
N_IN = 3 * SB_WIDTH + 3 * FOX_WIDTH + FOX_HEADS + RWKV_IN + N_BRANCHES * D_MODEL
D_FF = 4 * D_MODEL
RMS_EPS = 1e-6
RWKV_GN_EPS = 64e-5

kernel_name = 'hybrid_sb_fox_rwkv7_block'


def _split(x, sizes):
    points = np.cumsum(sizes)[:-1].tolist()
    return jnp.split(x, points, axis=-1)


def _rms_norm(x, gain):
    xf = x.astype(jnp.float32)
    y = xf * lax.rsqrt(jnp.mean(xf * xf, axis=-1, keepdims=True) + RMS_EPS)
    return (y * gain.astype(jnp.float32)).astype(x.dtype)


def _heads(x, n_heads):
    b, s, _ = x.shape
    return x.reshape(b, s, n_heads, -1).transpose(0, 2, 1, 3)


def _merge_heads(x):
    b, h, s, d = x.shape
    return x.transpose(0, 2, 1, 3).reshape(b, s, h * d)


def _query_blocks(x):
    b, h, s = x.shape[:3]
    x = x.reshape((b, h, s // Q_BLOCK, Q_BLOCK) + x.shape[3:])
    return jnp.moveaxis(x, 2, 0)


def _unblock(o):
    nb, b, h, qb, d = o.shape
    return o.transpose(1, 2, 0, 3, 4).reshape(b, h, nb * qb, d)


def stick_breaking_attention(q, k, v):
    s, d = q.shape[2], q.shape[3]
    scale = d ** -0.5
    kpos = jnp.arange(s)

    def block(args):
        qb, start = args
        z = jnp.einsum('bhqd,bhkd->bhqk', qb, k).astype(jnp.float32) * scale
        qpos = start + jnp.arange(Q_BLOCK)
        strict = kpos[None, :] < qpos[:, None]
        log_beta = jax.nn.log_sigmoid(z)
        log_rest = jnp.where(strict, jax.nn.log_sigmoid(-z), 0.0)
        between = lax.cumsum(log_rest, axis=3, reverse=True) - log_rest
        a = jnp.where(strict, jnp.exp(log_beta + between), 0.0)
        return jnp.einsum('bhqk,bhkd->bhqd', a.astype(v.dtype), v)

    starts = jnp.arange(s // Q_BLOCK, dtype=jnp.int32) * Q_BLOCK
    return _unblock(lax.map(block, (_query_blocks(q), starts)))


def forgetting_attention(q, k, v, log_f):
    s, d = q.shape[2], q.shape[3]
    scale = d ** -0.5
    kpos = jnp.arange(s)
    c = lax.cumsum(log_f.astype(jnp.float32), axis=2)

    def block(args):
        qb, cb, start = args
        z = jnp.einsum('bhqd,bhkd->bhqk', qb, k).astype(jnp.float32) * scale
        z = z + (cb[..., :, None] - c[..., None, :])
        qpos = start + jnp.arange(Q_BLOCK)
        causal = kpos[None, :] <= qpos[:, None]
        p = jax.nn.softmax(jnp.where(causal, z, -jnp.inf), axis=-1)
        return jnp.einsum('bhqk,bhkd->bhqd', p.astype(v.dtype), v)

    starts = jnp.arange(s // Q_BLOCK, dtype=jnp.int32) * Q_BLOCK
    return _unblock(lax.map(block, (_query_blocks(q), _query_blocks(c), starts)))


def rwkv7_time_mix(z, mu, w0, w_up, a0, a_up, g_up, k_k, k_a, r_k, ln_w, ln_b):
    b, s, _ = z.shape
    h, n = RWKV_HEADS, RWKV_HEAD_DIM
    z_prev = jnp.pad(z[:, :-1], ((0, 0), (1, 0), (0, 0)))
    z = z + (z_prev - z) * mu
    r, k, v, wd, ad, gd = _split(z, (RWKV_WIDTH,) * 3 + (DECAY_LORA, AAA_LORA, GATE_LORA))
    w_log = -jax.nn.softplus(-(w0 + jnp.tanh(wd) @ w_up)) - 0.5
    a = jax.nn.sigmoid(a0 + ad @ a_up)
    g = jax.nn.sigmoid(gd) @ g_up
    kk_raw = k * k_k
    k = k * (1 + (a - 1) * k_a)

    def per_head(t):
        return t.reshape(b, s, h, n).astype(jnp.float32)

    r_h, k_h, v_h, a_h, kk = map(per_head, (r, k, v, a, kk_raw))
    kk = kk / jnp.maximum(jnp.sqrt(jnp.sum(kk * kk, axis=-1, keepdims=True)), 1e-12)
    decay = jnp.exp(-jnp.exp(per_head(w_log)))

    def time_major(t):
        return t.transpose(1, 0, 2, 3).reshape(s // CHUNK, CHUNK, b, h, n)

    inputs = tuple(time_major(t) for t in (r_h, decay, k_h, v_h, kk, kk * a_h))

    def frame(state, inp):
        r_t, w_t, k_t, v_t, kk_t, kka_t = inp
        sa = jnp.einsum('bhvk,bhk->bhv', state, kk_t)
        state = (state * w_t[:, :, None, :] - sa[..., None] * kka_t[:, :, None, :]
                 + v_t[..., None] * k_t[:, :, None, :])
        return state, jnp.einsum('bhvk,bhk->bhv', state, r_t)

    def chunk(state, inp):
        return lax.scan(frame, state, inp)

    _, y = lax.scan(chunk, jnp.zeros((b, h, n, n), jnp.float32), inputs)
    y = y.reshape(s, b, h, n).transpose(1, 0, 2, 3)
    mean = jnp.mean(y, axis=-1, keepdims=True)
    var = jnp.mean(jnp.square(y - mean), axis=-1, keepdims=True)
    y = ((y - mean) * lax.rsqrt(var + RWKV_GN_EPS) * ln_w.astype(jnp.float32).reshape(h, n)
         + ln_b.astype(jnp.float32).reshape(h, n))
    y = y + jnp.sum(r_h * k_h * r_k.astype(jnp.float32), axis=-1, keepdims=True) * v_h
    return y.reshape(b, s, RWKV_WIDTH).astype(z.dtype) * g


def hybrid_mixer(u, w_in, b_forget, rwkv_mu, rwkv_w0, rwkv_w_up, rwkv_a0, rwkv_a_up, rwkv_g_up,
                 rwkv_k_k, rwkv_k_a, rwkv_r_k, rwkv_ln_w, rwkv_ln_b,
                 w_branch_a, w_branch_b, w_branch_c, w_out):
    proj = u @ w_in
    sb, fox, rw, gates = _split(proj, (3 * SB_WIDTH, 3 * FOX_WIDTH + FOX_HEADS, RWKV_IN,
                                       N_BRANCHES * D_MODEL))
    q_a, k_a, v_a = _split(sb, (SB_WIDTH,) * 3)
    y_a = _merge_heads(stick_breaking_attention(_heads(q_a, SB_HEADS), _heads(k_a, SB_HEADS),
                                                _heads(v_a, SB_HEADS)))
    q_b, k_b, v_b, f_b = _split(fox, (FOX_WIDTH,) * 3 + (FOX_HEADS,))
    log_f = jax.nn.log_sigmoid((f_b + b_forget).astype(jnp.float32)).transpose(0, 2, 1)
    y_b = _merge_heads(forgetting_attention(_heads(q_b, FOX_HEADS), _heads(k_b, FOX_HEADS),
                                            _heads(v_b, FOX_HEADS), log_f))
    y_c = rwkv7_time_mix(rw, rwkv_mu, rwkv_w0, rwkv_w_up, rwkv_a0, rwkv_a_up, rwkv_g_up,
                         rwkv_k_k, rwkv_k_a, rwkv_r_k, rwkv_ln_w, rwkv_ln_b)
    g_a, g_b, g_c = _split(jax.nn.sigmoid(gates), (D_MODEL,) * 3)
    m = g_a * (y_a @ w_branch_a) + g_b * (y_b @ w_branch_b) + g_c * (y_c @ w_branch_c)
    return m @ w_out


def setup_inputs(seed: int = 0) -> dict:
    key = jax.random.key(seed)
    ks = jax.random.split(key, 24)
    L, D = DEPTH, D_MODEL

    def nrm(k, shape, scale):
        return jax.random.normal(k, shape, jnp.float32) * scale

    return {
        'x': nrm(ks[0], (BATCH, SEQ, D), 1.0),
        'norm_mix_pre': 1.0 + nrm(ks[1], (L, D), 0.05),
        'norm_mix_post': 1.0 + nrm(ks[2], (L, D), 0.05),
        'norm_mlp_pre': 1.0 + nrm(ks[3], (L, D), 0.05),
        'norm_mlp_post': 1.0 + nrm(ks[4], (L, D), 0.05),
        'w_in': nrm(ks[5], (L, D, N_IN), D ** -0.5),
        'b_forget': 1.0 + nrm(ks[6], (L, FOX_HEADS), 0.5),
        'rwkv_mu': jax.random.uniform(ks[7], (L, RWKV_IN), jnp.float32),
        'rwkv_w0': nrm(ks[8], (L, RWKV_WIDTH), 0.5),
        'rwkv_w_up': nrm(ks[9], (L, DECAY_LORA, RWKV_WIDTH), 0.5 * DECAY_LORA ** -0.5),
        'rwkv_a0': nrm(ks[10], (L, RWKV_WIDTH), 0.1),
        'rwkv_a_up': nrm(ks[11], (L, AAA_LORA, RWKV_WIDTH), 0.5 * AAA_LORA ** -0.5),
        'rwkv_g_up': nrm(ks[12], (L, GATE_LORA, RWKV_WIDTH), GATE_LORA ** -0.5),
        'rwkv_k_k': 0.85 + nrm(ks[13], (L, RWKV_WIDTH), 0.05),
        'rwkv_k_a': 1.0 + nrm(ks[14], (L, RWKV_WIDTH), 0.05),
        'rwkv_r_k': nrm(ks[15], (L, RWKV_HEADS, RWKV_HEAD_DIM), 0.1),
        'rwkv_ln_w': 1.0 + nrm(ks[16], (L, RWKV_WIDTH), 0.05),
        'rwkv_ln_b': nrm(ks[17], (L, RWKV_WIDTH), 0.01),
        'w_branch_a': nrm(ks[18], (L, SB_WIDTH, D), SB_WIDTH ** -0.5),
        'w_branch_b': nrm(ks[19], (L, FOX_WIDTH, D), FOX_WIDTH ** -0.5),
        'w_branch_c': nrm(ks[20], (L, RWKV_WIDTH, D), RWKV_WIDTH ** -0.5),
        'w_out': nrm(ks[21], (L, D, D), D ** -0.5),
        'w_mlp_up': nrm(ks[22], (L, D, D_FF), D ** -0.5),
        'w_mlp_down': nrm(ks[23], (L, D_FF, D), D_FF ** -0.5),
    }


def reference(x, norm_mix_pre, norm_mix_post, norm_mlp_pre, norm_mlp_post, w_in, b_forget,
              rwkv_mu, rwkv_w0, rwkv_w_up, rwkv_a0, rwkv_a_up, rwkv_g_up, rwkv_k_k, rwkv_k_a,
              rwkv_r_k, rwkv_ln_w, rwkv_ln_b, w_branch_a, w_branch_b, w_branch_c, w_out,
              w_mlp_up, w_mlp_down):
    for l in range(DEPTH):
        u = _rms_norm(x, norm_mix_pre[l])
        mix = hybrid_mixer(u, w_in[l], b_forget[l], rwkv_mu[l], rwkv_w0[l], rwkv_w_up[l],
                           rwkv_a0[l], rwkv_a_up[l], rwkv_g_up[l], rwkv_k_k[l], rwkv_k_a[l],
                           rwkv_r_k[l], rwkv_ln_w[l], rwkv_ln_b[l], w_branch_a[l], w_branch_b[l],
                           w_branch_c[l], w_out[l])
        x = x + _rms_norm(mix, norm_mix_post[l])
        hdn = jnp.square(jax.nn.relu(_rms_norm(x, norm_mlp_pre[l]) @ w_mlp_up[l]))
        x = x + _rms_norm(hdn @ w_mlp_down[l], norm_mlp_post[l])
    return x
```

```cpp
#include <hip/hip_runtime.h>
#include <hip/hip_cooperative_groups.h>
#include <cstdio>
#include <cstdint>
namespace cg = cooperative_groups;

#define LAS __attribute__((address_space(3)))
typedef unsigned short bf16_t;
typedef short bf16x8 __attribute__((ext_vector_type(8)));
typedef float f32x4 __attribute__((ext_vector_type(4)));
typedef float f32x16 __attribute__((ext_vector_type(16)));
typedef unsigned u32x4 __attribute__((ext_vector_type(4)));
typedef unsigned u32x2 __attribute__((ext_vector_type(2)));

constexpr int TT = 16384;
constexpr int SEQ = 4096;
constexpr int DM = 2048;
constexpr int NP = 11776;
constexpr int NWIN = 12800;
constexpr int FF = 8192;
constexpr int C_QA = 0, C_KA = 512, C_QB = 1024, C_KB = 1536, C_RW = 2048, C_FB = 5408, C_GATE = 5632;
constexpr int NLORA = 3072, KLORA = 384;
constexpr int GATE1 = 512, GATE2 = 5632;
constexpr float RMS_EPS = 1e-6f, GN_EPS = 64e-5f;

constexpr size_t MiB = 1u << 20;
constexpr size_t WS_WIN = 1 * MiB, WS_WBR = 51 * MiB, WS_WOUT = 59 * MiB, WS_WUP = 67 * MiB, WS_WDN = 99 * MiB, WS_WLORA = 131 * MiB,
                 WS_C = 134 * MiB, WS_U = 135 * MiB, WS_BIG = 199 * MiB, WS_VT = 567 * MiB, WS_LA = 599 * MiB, WS_LO = 611 * MiB, WS_YR = 707 * MiB, WS_BON = 739 * MiB, WS_YAB = 740 * MiB, WS_END = 772 * MiB;
constexpr size_t WS_TMP = WS_BIG + 256 * MiB;
constexpr int LDS_BYTES = 147456;

struct Params { const float* in[24]; float* out; unsigned char* ws; };


#define AS4 __attribute__((address_space(4)))
__device__ __forceinline__ const float* arg_in(int k) { const char AS4* ka = (const char AS4*)__builtin_amdgcn_kernarg_segment_ptr(); asm volatile("" : "+s"(ka)); return *(const float* const AS4*)(ka + 8 * k); }
__device__ __forceinline__ float* arg_out() { const char AS4* ka = (const char AS4*)__builtin_amdgcn_kernarg_segment_ptr(); asm volatile("" : "+s"(ka)); return *(float* const AS4*)(ka + 192); }
__device__ __forceinline__ unsigned char* arg_ws() { const char AS4* ka = (const char AS4*)__builtin_amdgcn_kernarg_segment_ptr(); asm volatile("" : "+s"(ka)); return *(unsigned char* const AS4*)(ka + 200); }
__device__ __forceinline__ float bf_lo(unsigned u) { return __uint_as_float(u << 16); }
__device__ __forceinline__ float bf_hi(unsigned u) { return __uint_as_float(u & 0xffff0000u); }
__device__ __forceinline__ float bf1(bf16_t h) { return __uint_as_float(((unsigned)h) << 16); }
__device__ __forceinline__ unsigned cvt_pk_bf16(float lo, float hi) { unsigned r; asm volatile("v_cvt_pk_bf16_f32 %0, %1, %2" : "=v"(r) : "v"(lo), "v"(hi)); return r; }
__device__ __forceinline__ float sigmoidf_(float x) { return __builtin_amdgcn_rcpf(1.0f + __expf(-x)); }
template <int CTRL> __device__ __forceinline__ float dppf(float x) { return __builtin_bit_cast(float, __builtin_amdgcn_mov_dpp(__builtin_bit_cast(int, x), CTRL, 0xf, 0xf, true)); }
__device__ __forceinline__ float sum8(float x) { x += dppf<0xB1>(x); x += dppf<0x4E>(x); x += dppf<0x141>(x); return x; }
__device__ __forceinline__ float sum16(float x) { x = sum8(x); x += dppf<0x140>(x); return x; }
__device__ __forceinline__ float xor16_sum(float x) { float a = x, b = x; asm volatile("s_nop 1\n\tv_permlane16_swap_b32 %0, %1\n\ts_nop 1" : "+v"(a), "+v"(b)); return a + b; }
__device__ __forceinline__ float sum32(float x) { return xor16_sum(sum16(x)); }
__device__ __forceinline__ float xor32_sum(float x) { float a = x, b = x; asm volatile("s_nop 1\n\tv_permlane32_swap_b32 %0, %1\n\ts_nop 1" : "+v"(a), "+v"(b)); return a + b; }
__device__ __forceinline__ float wave_sum(float v) { return xor32_sum(sum32(v)); }
__device__ __forceinline__ void unpack8(const u32x4 v, float (&f)[8]) {
    f[0] = bf_lo(v.x); f[1] = bf_hi(v.x); f[2] = bf_lo(v.y); f[3] = bf_hi(v.y); f[4] = bf_lo(v.z); f[5] = bf_hi(v.z); f[6] = bf_lo(v.w); f[7] = bf_hi(v.w);
}
__device__ __forceinline__ u32x4 pack8(const float (&f)[8]) {
    u32x4 w; w.x = cvt_pk_bf16(f[0], f[1]); w.y = cvt_pk_bf16(f[2], f[3]); w.z = cvt_pk_bf16(f[4], f[5]); w.w = cvt_pk_bf16(f[6], f[7]); return w;
}

namespace pg8 {
constexpr int BM = 256, BK = 64, HALF = 128, HTB = HALF * BK * 2, STAGE_BYTES = 8 * HTB, NXCD = 8, WGM = 8;
__device__ __forceinline__ int lds_byte(int r, int c) { const int st = (r >> 4) * 2 + (c >> 5), rr = r & 15, cc = c & 31, ob = rr * 64 + cc * 2; return st * 1024 + (ob ^ (((ob >> 9) & 1) << 5)); }
__device__ __forceinline__ void stage_rc(int b, int& R, int& C) { const int st = b / 1024, sb = b % 1024, swz = sb ^ (((sb >> 9) & 1) << 5); R = (st >> 1) * 16 + swz / 64; C = (st & 1) * 32 + (swz % 64) / 2; }
__device__ __forceinline__ int perm32(int rho) { const int n = rho >> 4, i = rho & 15; return 8 * (i >> 2) + 4 * n + (i & 3); }
struct Unit { int pm, pn; };
struct Gemm { const bf16_t* A; const bf16_t* Bt; int M, N, K; int lda; long ajump; };
struct StaticOrder {
    int nM, nN, nwg, G, c;
    __device__ void init(int M, int N, int G_, int c_) { nM = M / BM; nN = N / BM; nwg = nM * nN; G = G_; c = c_; }
    __device__ bool next(int i, Unit& u) const {
        const long L = (long)i * G + c; if (L >= nwg) return false;
        int wgid = (int)L; { const int q = nwg / NXCD, r = nwg % NXCD, xcd = wgid % NXCD, off = wgid / NXCD; wgid = (xcd < r ? xcd * (q + 1) : r * (q + 1) + (xcd - r) * q) + off; }
        const int nig = WGM * nN, gid = wgid / nig, fm = gid * WGM, gsz = (nM - fm) < WGM ? (nM - fm) : WGM;
        u.pm = fm + ((wgid % nig) % gsz); u.pn = (wgid % nig) / gsz; return true;
    }
};

template <class F> struct EpiStore {
    static constexpr bool PERM = true, GATED = false;
    bf16_t* O; int ldc; F f;
    __device__ __forceinline__ void rescale(f32x4 (&)[2][2][4][2], const Unit&, int, int, int, int, int) const {}
    __device__ __forceinline__ void operator()(f32x4 (&acc)[2][2][4][2], const Unit& u, int wr, int wc, int fr, int fq) const {
        int t2_ = threadIdx.x; asm volatile("" : "+v"(t2_)); (void)wr; (void)wc; (void)fr; (void)fq;
        const int row0 = u.pm * BM + ((t2_ >> 8) & 1) * 64 + (t2_ & 15), col0 = u.pn * BM + ((t2_ >> 6) & 3) * 32 + 8 * ((t2_ >> 4) & 3);
#pragma unroll
        for (int ai = 0; ai < 2; ++ai)
#pragma unroll
            for (int m = 0; m < 4; ++m) {
                bf16_t* rowp = O + (size_t)(row0 + ai * HALF + m * 16) * ldc + col0;
#pragma unroll
                for (int bj = 0; bj < 2; ++bj) {
                    f32x4 v0 = acc[ai][bj][m][0], v1 = acc[ai][bj][m][1];
                    f(v0, v1, u.pn, col0 + bj * HALF);
                    u32x4 w; w.x = cvt_pk_bf16(v0[0], v0[1]); w.y = cvt_pk_bf16(v0[2], v0[3]); w.z = cvt_pk_bf16(v1[0], v1[1]); w.w = cvt_pk_bf16(v1[2], v1[3]);
                    *(u32x4*)(rowp + bj * HALF) = w;
                }
            }
    }
};
struct FId { __device__ __forceinline__ void operator()(f32x4&, f32x4&, int, int) const {} };
struct FProj {
    int gate_pn;
    __device__ __forceinline__ void operator()(f32x4& a, f32x4& b, int pn, int) const {
        if (pn >= gate_pn) {
#pragma unroll
            for (int j = 0; j < 4; ++j) { a[j] = fmaxf(sigmoidf_(a[j]), 1e-18f); b[j] = fmaxf(sigmoidf_(b[j]), 1e-18f); }
        }
    }
};
struct FRelu2 { __device__ __forceinline__ void operator()(f32x4& a, f32x4& b, int, int) const {
#pragma unroll
        for (int j = 0; j < 4; ++j) { float x = fmaxf(a[j], 0.f); a[j] = x * x; float y = fmaxf(b[j], 0.f); b[j] = y * y; } } };
struct FLora {
    const float* w0; const float* a0;
    __device__ __forceinline__ void operator()(f32x4& a, f32x4& b, int pn, int col) const {
        if (pn < 8) {
            const float* pp = (pn < 4) ? (w0 + col) : (a0 + col - 1024);
            const float sc = (pn < 4) ? -0.6065306597126334f : 1.0f;
            const f32x4 p0 = *(const f32x4*)pp, p1 = *(const f32x4*)(pp + 4);
#pragma unroll
            for (int j = 0; j < 4; ++j) { a[j] = sc * sigmoidf_(a[j] + p0[j]); b[j] = sc * sigmoidf_(b[j] + p1[j]); }
        }
    }
};
struct EpiBranch {
    static constexpr bool PERM = true, GATED = true;
    bf16_t* O; const bf16_t* Gt;
    __device__ __forceinline__ void rescale(f32x4 (&acc)[2][2][4][2], const Unit& u, int seg, int wr, int wc, int fr, int fq) const {
        int t2_ = threadIdx.x; asm volatile("" : "+v"(t2_)); (void)wr; (void)wc; (void)fr; (void)fq;
        const int row0 = u.pm * BM + ((t2_ >> 8) & 1) * 64 + (t2_ & 15), col0 = u.pn * BM + ((t2_ >> 6) & 3) * 32 + 8 * ((t2_ >> 4) & 3);
#pragma unroll
        for (int ai = 0; ai < 2; ++ai)
#pragma unroll
            for (int m = 0; m < 4; ++m) {
                const bf16_t* gp = Gt + (size_t)(row0 + ai * HALF + m * 16) * NP + seg * 2048 + col0;
#pragma unroll
                for (int bj = 0; bj < 2; ++bj) {
                    const u32x4 ga = *(const u32x4*)(gp + bj * HALF), gb = *(const u32x4*)(gp + bj * HALF + 2048);
                    float fa[8], fb[8]; unpack8(ga, fa); unpack8(gb, fb);
#pragma unroll
                    for (int j = 0; j < 4; ++j) { acc[ai][bj][m][0][j] *= __fdividef(fa[j], fb[j]); acc[ai][bj][m][1][j] *= __fdividef(fa[4 + j], fb[4 + j]); }
                    asm volatile("" : "+v"(acc[ai][bj][m][0]), "+v"(acc[ai][bj][m][1]) :: "memory");
                }
            }
    }
    __device__ __forceinline__ void operator()(f32x4 (&acc)[2][2][4][2], const Unit& u, int wr, int wc, int fr, int fq) const {
        int t2_ = threadIdx.x; asm volatile("" : "+v"(t2_)); (void)wr; (void)wc; (void)fr; (void)fq;
        const int row0 = u.pm * BM + ((t2_ >> 8) & 1) * 64 + (t2_ & 15), col0 = u.pn * BM + ((t2_ >> 6) & 3) * 32 + 8 * ((t2_ >> 4) & 3);
#pragma unroll
        for (int ai = 0; ai < 2; ++ai)
#pragma unroll
            for (int m = 0; m < 4; ++m) {
                const size_t r = (size_t)(row0 + ai * HALF + m * 16);
#pragma unroll
                for (int bj = 0; bj < 2; ++bj) {
                    const u32x4 gc = *(const u32x4*)(Gt + r * NP + 4096 + col0 + bj * HALF);
                    float fc[8]; unpack8(gc, fc);
                    f32x4 v0 = acc[ai][bj][m][0], v1 = acc[ai][bj][m][1];
                    u32x4 w; w.x = cvt_pk_bf16(v0[0] * fc[0], v0[1] * fc[1]); w.y = cvt_pk_bf16(v0[2] * fc[2], v0[3] * fc[3]);
                    w.z = cvt_pk_bf16(v1[0] * fc[4], v1[1] * fc[5]); w.w = cvt_pk_bf16(v1[2] * fc[6], v1[3] * fc[7]);
                    *(u32x4*)(O + r * DM + col0 + bj * HALF) = w;
                    asm volatile("" ::: "memory");
                }
            }
    }
};

template <class Epi>
__device__ __forceinline__ void gemm_phase(LAS unsigned char* lds, const Gemm g, const StaticOrder& S, const Epi& E) {
    int tid_ = threadIdx.x; asm volatile("" : "+v"(tid_));
    const int tid = tid_, wid = __builtin_amdgcn_readfirstlane(tid >> 6), lane = tid & 63, wr = wid >> 2, wc = wid & 3, fr = lane & 15, fq = lane >> 4;
    const int K = g.K, nt = K / BK;
    unsigned voffA[2], voffB[2];
#pragma unroll
    for (int i = 0; i < 2; ++i) { int R, C; stage_rc(tid * 16 + i * 8192, R, C); const int Rb = Epi::PERM ? ((R & ~31) + perm32(R & 31)) : R;
        voffA[i] = (unsigned)(R * g.lda + C) * 2u; voffB[i] = (unsigned)(Rb * K + C) * 2u; }
    const size_t kstep = (size_t)(BK * 2);
    const size_t hstep = (size_t)HALF * K * 2;
    const size_t tstep = 2 * hstep;
    const size_t hstepA = (size_t)HALF * g.lda * 2, tstepA = 2 * hstepA;
    const long aj = g.ajump;
#define PG8_AP(base, tt) ((base) + (size_t)(tt) * kstep + (((tt) >= 16) ? aj : 0L))
    const unsigned ldsw = (unsigned)wid * 1024u;
    const int aoff = lds_byte(wr * 64 + fr, fq * 8), boff = lds_byte(wc * 32 + fr, fq * 8);
#define PG8_SA(b, h) (((b) * 2 + (h)) * HTB)
#define PG8_SB(b, h) ((4 + (b) * 2 + (h)) * HTB)
#define PG8_STAGE(bufoff, gbase, voff) do { _Pragma("unroll") for (int _i = 0; _i < 2; ++_i) \
        __builtin_amdgcn_global_load_lds((const unsigned*)((const char*)(gbase) + (voff)[_i]), (LAS unsigned*)(lds + (bufoff) + ldsw + _i * 8192), 16, 0, 0); } while (0)
#define PG8_LDA(dst, b, h) do { _Pragma("unroll") for (int m = 0; m < 4; ++m) _Pragma("unroll") for (int k = 0; k < 2; ++k) dst[m][k] = *(const LAS bf16x8*)(lds + PG8_SA(b, h) + aoff + m * 2048 + k * 1024); } while (0)
#define PG8_LDB(dst, b, h) do { _Pragma("unroll") for (int n = 0; n < 2; ++n) _Pragma("unroll") for (int k = 0; k < 2; ++k) dst[n][k] = *(const LAS bf16x8*)(lds + PG8_SB(b, h) + boff + n * 2048 + k * 1024); } while (0)
#define PG8_MMA(ai, bj, At, Bt) do { __builtin_amdgcn_s_setprio(1); _Pragma("unroll") for (int m = 0; m < 4; ++m) _Pragma("unroll") for (int n = 0; n < 2; ++n) _Pragma("unroll") for (int k = 0; k < 2; ++k) \
        acc[ai][bj][m][n] = __builtin_amdgcn_mfma_f32_16x16x32_bf16(Bt[n][k], At[m][k], acc[ai][bj][m][n], 0, 0, 0); __builtin_amdgcn_s_setprio(0); } while (0)
#define PG8_WAIT_V(n) asm volatile("s_waitcnt vmcnt(" #n ")" ::: "memory")
#define PG8_WAIT_L(n) asm volatile("s_waitcnt lgkmcnt(" #n ")" ::: "memory")
#define PG8_BAR __builtin_amdgcn_s_barrier()
#define PG8_SCHED __builtin_amdgcn_sched_barrier(0)
    Unit cur, nxt; int ui = 0;
    if (!S.next(0, cur)) return;
    f32x4 acc[2][2][4][2];
#pragma unroll
    for (int a = 0; a < 2; ++a)
#pragma unroll
        for (int b = 0; b < 2; ++b)
#pragma unroll
            for (int m = 0; m < 4; ++m)
#pragma unroll
                for (int n = 0; n < 2; ++n) acc[a][b][m][n] = (f32x4){0.f, 0.f, 0.f, 0.f};
    bf16x8 At[4][2], B0[2][2], B1[2][2];
    const char* cA = (const char*)g.A + (size_t)cur.pm * tstepA; const char* cB = (const char*)g.Bt + (size_t)cur.pn * tstep;
    PG8_STAGE(PG8_SB(0, 0), cB, voffB); PG8_STAGE(PG8_SB(0, 1), cB + hstep, voffB); PG8_STAGE(PG8_SA(0, 0), cA, voffA); PG8_STAGE(PG8_SA(0, 1), cA + hstepA, voffA);
    if (wr == 1) PG8_BAR;
    PG8_WAIT_V(2); PG8_BAR;
    PG8_STAGE(PG8_SB(1, 0), cB + kstep, voffB); PG8_STAGE(PG8_SA(1, 0), cA + kstep, voffA); PG8_STAGE(PG8_SB(1, 1), cB + hstep + kstep, voffB);
    PG8_WAIT_V(6); PG8_BAR;
    for (;;) {
        const bool has_next = S.next(ui + 1, nxt);
        const char* nA = has_next ? (const char*)g.A + (size_t)nxt.pm * tstepA : cA; const char* nB = has_next ? (const char*)g.Bt + (size_t)nxt.pn * tstep : cB;
#pragma unroll 1
        for (int t = 0; t < nt; t += 2) {
            if constexpr (Epi::GATED) { if (t == 8 || t == 16) E.rescale(acc, cur, t == 8 ? 0 : 1, wr, wc, fr, fq); }
            const bool last = (t == nt - 2);
            const char* a1 = PG8_AP(cA, t + 1);
            const char* a2 = last ? nA : PG8_AP(cA, t + 2); const char* b2 = last ? nB : cB + (size_t)(t + 2) * kstep;
            const char* a3 = last ? nA + kstep : PG8_AP(cA, t + 3); const char* b3 = b2 + kstep;
            PG8_LDB(B0, 0, 0); PG8_LDB(B1, 0, 1); PG8_SCHED; PG8_LDA(At, 0, 0); PG8_STAGE(PG8_SA(1, 1), a1 + hstepA, voffA);
            PG8_WAIT_V(8); PG8_WAIT_L(0); PG8_BAR; PG8_MMA(0, 0, At, B0); PG8_MMA(0, 1, At, B1); PG8_BAR; PG8_SCHED;
            PG8_LDA(At, 0, 1); PG8_STAGE(PG8_SB(0, 0), b2, voffB); PG8_STAGE(PG8_SB(0, 1), b2 + hstep, voffB); PG8_STAGE(PG8_SA(0, 0), a2, voffA);
            PG8_WAIT_V(8); PG8_WAIT_L(0); PG8_BAR; PG8_MMA(1, 0, At, B0); PG8_MMA(1, 1, At, B1); PG8_BAR; PG8_SCHED;
            PG8_LDB(B0, 1, 0); PG8_LDB(B1, 1, 1); PG8_SCHED; PG8_LDA(At, 1, 0); PG8_STAGE(PG8_SA(0, 1), a2 + hstepA, voffA);
            PG8_WAIT_V(8); PG8_WAIT_L(0); PG8_BAR; PG8_MMA(0, 0, At, B0); PG8_MMA(0, 1, At, B1); PG8_BAR; PG8_SCHED;
            PG8_LDA(At, 1, 1); PG8_STAGE(PG8_SB(1, 0), b3, voffB); PG8_STAGE(PG8_SB(1, 1), b3 + hstep, voffB); PG8_STAGE(PG8_SA(1, 0), a3, voffA);
            PG8_WAIT_V(8); PG8_WAIT_L(0); PG8_BAR; PG8_MMA(1, 0, At, B0); PG8_MMA(1, 1, At, B1); PG8_BAR; PG8_SCHED;
        }
        if (wr == 0) PG8_BAR;
        E(acc, cur, wr, wc, fr, fq);
        if (!has_next) break;
#pragma unroll
        for (int a = 0; a < 2; ++a)
#pragma unroll
            for (int b = 0; b < 2; ++b)
#pragma unroll
                for (int m = 0; m < 4; ++m)
#pragma unroll
                    for (int n = 0; n < 2; ++n) acc[a][b][m][n] = (f32x4){0.f, 0.f, 0.f, 0.f};
        cur = nxt; cA = nA; cB = nB; ++ui;
        if (wr == 1) PG8_BAR;
    }
    PG8_WAIT_V(0);
    PG8_BAR;
#undef PG8_AP
#undef PG8_SA
#undef PG8_SB
#undef PG8_STAGE
#undef PG8_LDA
#undef PG8_LDB
#undef PG8_MMA
#undef PG8_WAIT_V
#undef PG8_WAIT_L
#undef PG8_BAR
#undef PG8_SCHED
}
}

__device__ __forceinline__ int win_src(int n) {
    if (n < 1024) return n;
    if (n < 1536) return 1536 + (n - 1024);
    if (n < 2048) return 2048 + (n - 1536);
    if (n < 5408) return 3076 + (n - 2048);
    if (n < 5412) return 3072 + (n - 5408);
    if (n < 5632) return -1;
    if (n < 11776) return 6436 + (n - 5632);
    if (n < 12288) return 1024 + (n - 11776);
    return 2560 + (n - 12288);
}
__device__ __forceinline__ void tr_item(const float* W, int N, bf16_t* WT, int ldk, int koff, int k0, int nd0, int nsrc4, LAS float* scr, int lane) {
#pragma unroll 8
    for (int i = 0; i < 16; ++i) { const int kk = 4 * i + (lane >> 4);
        const f32x4 v = nsrc4 >= 0 ? *(const f32x4*)(W + (size_t)(k0 + kk) * N + nsrc4) : (f32x4){0.f, 0.f, 0.f, 0.f};
        *(LAS f32x4*)(scr + kk * 68 + ((4 * (lane & 15)) ^ (8 * ((kk >> 3) & 7)))) = v; }
    asm volatile("s_waitcnt lgkmcnt(0)" ::: "memory");
    const int c = lane & 7;
#pragma unroll
    for (int j = 0; j < 8; ++j) { const int n = (lane >> 3) + 8 * j; const LAS float* s = scr + (8 * c) * 68 + (n ^ (8 * c));
        u32x4 o; o.x = cvt_pk_bf16(s[0 * 68], s[1 * 68]); o.y = cvt_pk_bf16(s[2 * 68], s[3 * 68]); o.z = cvt_pk_bf16(s[4 * 68], s[5 * 68]); o.w = cvt_pk_bf16(s[6 * 68], s[7 * 68]);
        *(u32x4*)(WT + (size_t)(nd0 + n) * ldk + koff + k0 + 8 * c) = o; }
    asm volatile("s_waitcnt lgkmcnt(0)" ::: "memory");
}
__device__ __forceinline__ void convert_weights(const Params& p, int l, LAS unsigned char* lds, int gw, int ngw, int wave, int lane, int gtid, int nthr) {
    LAS float* scr = (LAS float*)(lds + wave * 17408);
    unsigned char* ws = arg_ws();
    bf16_t* WIN = (bf16_t*)(ws + WS_WIN); bf16_t* WBR = (bf16_t*)(ws + WS_WBR); bf16_t* WOUT = (bf16_t*)(ws + WS_WOUT);
    bf16_t* WUP = (bf16_t*)(ws + WS_WUP); bf16_t* WDN = (bf16_t*)(ws + WS_WDN); bf16_t* WLO = (bf16_t*)(ws + WS_WLORA);
    const float* w_in = arg_in(5) + (size_t)l * DM * 12580;
    const float* wba = arg_in(18) + (size_t)l * 512 * DM; const float* wbb = arg_in(19) + (size_t)l * 512 * DM; const float* wbc = arg_in(20) + (size_t)l * 1024 * DM;
    const float* wout = arg_in(21) + (size_t)l * DM * DM; const float* wup = arg_in(22) + (size_t)l * DM * FF; const float* wdn = arg_in(23) + (size_t)l * FF * DM;
    constexpr int I_IN = 32 * 200, I_BA = 8 * 32, I_BC = 16 * 32, I_OUT = 32 * 32, I_UP = 32 * 128, I_DN = 128 * 32;
    constexpr int NIT = I_IN + 2 * I_BA + I_BC + I_OUT + I_UP + I_DN;
    const int n4 = 4 * (lane & 15);
    for (int it = gw; it < NIT; it += ngw) {
        int r = it;
        if (r < I_IN) { const int kb = r / 200, nb = r % 200; tr_item(w_in, 12580, WIN, DM, 0, 64 * kb, 64 * nb, win_src(64 * nb + n4), scr, lane); continue; } r -= I_IN;
        if (r < I_BA) { const int kb = r / 32, nb = r % 32; tr_item(wba, DM, WBR, DM, 0, 64 * kb, 64 * nb, 64 * nb + n4, scr, lane); continue; } r -= I_BA;
        if (r < I_BA) { const int kb = r / 32, nb = r % 32; tr_item(wbb, DM, WBR, DM, 512, 64 * kb, 64 * nb, 64 * nb + n4, scr, lane); continue; } r -= I_BA;
        if (r < I_BC) { const int kb = r / 32, nb = r % 32; tr_item(wbc, DM, WBR, DM, 1024, 64 * kb, 64 * nb, 64 * nb + n4, scr, lane); continue; } r -= I_BC;
        if (r < I_OUT) { const int kb = r / 32, nb = r % 32; tr_item(wout, DM, WOUT, DM, 0, 64 * kb, 64 * nb, 64 * nb + n4, scr, lane); continue; } r -= I_OUT;
        if (r < I_UP) { const int kb = r / 128, nb = r % 128; tr_item(wup, FF, WUP, DM, 0, 64 * kb, 64 * nb, 64 * nb + n4, scr, lane); continue; } r -= I_UP;
        { const int kb = r / 32, nb = r % 32; tr_item(wdn, DM, WDN, FF, 0, 64 * kb, 64 * nb, 64 * nb + n4, scr, lane); }
    }
    const float* w_up = arg_in(9) + (size_t)l * 64 * 1024; const float* a_up = arg_in(11) + (size_t)l * 64 * 1024; const float* g_up = arg_in(12) + (size_t)l * 160 * 1024;
    for (int it = gtid; it < NLORA * (KLORA / 8); it += nthr) {
        const int n = it % NLORA, kc = it / NLORA, k0 = 8 * kc;
        float v[8];
#pragma unroll
        for (int e = 0; e < 8; ++e) { const int k = k0 + e; float x = 0.f;
            if (n < 1024) { if (k < 64) x = w_up[(size_t)k * 1024 + n]; }
            else if (n < 2048) { if (k >= 64 && k < 128) x = a_up[(size_t)(k - 64) * 1024 + (n - 1024)]; }
            else { if (k >= 128 && k < 288) x = g_up[(size_t)(k - 128) * 1024 + (n - 2048)]; }
            v[e] = x; }
        *(u32x4*)(WLO + (size_t)n * KLORA + k0) = pack8(v);
    }
}

template <bool HAS_T>
__device__ __forceinline__ void norm_rows(const float* xin, const bf16_t* t, const float* gpost, float* xout, const float* gpre, bf16_t* U, int gw, int ngw, int lane) {
    f32x4 xa[4][2], xn[4][2]; u32x4 tv[4], tn[4];
    if (gw < TT) {
        const size_t rb = (size_t)gw * DM;
#pragma unroll
        for (int j = 0; j < 4; ++j) { const int c = j * 512 + lane * 8; xn[j][0] = *(const f32x4*)(xin + rb + c); xn[j][1] = *(const f32x4*)(xin + rb + c + 4);
            if constexpr (HAS_T) tn[j] = *(const u32x4*)(t + rb + c); }
    }
    for (int m = gw; m < TT; m += ngw) {
        const size_t rb = (size_t)m * DM;
#pragma unroll
        for (int j = 0; j < 4; ++j) { xa[j][0] = xn[j][0]; xa[j][1] = xn[j][1]; if constexpr (HAS_T) tv[j] = tn[j]; }
        if (m + ngw < TT) {
            const size_t rn = (size_t)(m + ngw) * DM;
#pragma unroll
            for (int j = 0; j < 4; ++j) { const int c = j * 512 + lane * 8; xn[j][0] = *(const f32x4*)(xin + rn + c); xn[j][1] = *(const f32x4*)(xin + rn + c + 4);
                if constexpr (HAS_T) tn[j] = *(const u32x4*)(t + rn + c); }
        }
        if constexpr (HAS_T) {
            float ss = 0.f;
#pragma unroll
            for (int j = 0; j < 4; ++j) { float f[8]; unpack8(tv[j], f);
#pragma unroll
                for (int e = 0; e < 8; ++e) ss += f[e] * f[e]; }
            ss = wave_sum(ss);
            const float rs = rsqrtf(ss * (1.0f / DM) + RMS_EPS);
#pragma unroll
            for (int j = 0; j < 4; ++j) { const int c = j * 512 + lane * 8; float f[8]; unpack8(tv[j], f);
                const f32x4 g0 = *(const f32x4*)(gpost + c), g1 = *(const f32x4*)(gpost + c + 4);
#pragma unroll
                for (int e = 0; e < 4; ++e) { xa[j][0][e] += f[e] * rs * g0[e]; xa[j][1][e] += f[4 + e] * rs * g1[e]; }
                *(f32x4*)(xout + rb + c) = xa[j][0]; *(f32x4*)(xout + rb + c + 4) = xa[j][1]; }
        }
        if (gpre == nullptr) continue;
        float s2 = 0.f;
#pragma unroll
        for (int j = 0; j < 4; ++j)
#pragma unroll
            for (int e = 0; e < 4; ++e) s2 += xa[j][0][e] * xa[j][0][e] + xa[j][1][e] * xa[j][1][e];
        s2 = wave_sum(s2);
        const float r2 = rsqrtf(s2 * (1.0f / DM) + RMS_EPS);
#pragma unroll
        for (int j = 0; j < 4; ++j) { const int c = j * 512 + lane * 8;
            const f32x4 g0 = *(const f32x4*)(gpre + c), g1 = *(const f32x4*)(gpre + c + 4);
            u32x4 w; w.x = cvt_pk_bf16(xa[j][0][0] * r2 * g0[0], xa[j][0][1] * r2 * g0[1]); w.y = cvt_pk_bf16(xa[j][0][2] * r2 * g0[2], xa[j][0][3] * r2 * g0[3]);
            w.z = cvt_pk_bf16(xa[j][1][0] * r2 * g1[0], xa[j][1][1] * r2 * g1[1]); w.w = cvt_pk_bf16(xa[j][1][2] * r2 * g1[2], xa[j][1][3] * r2 * g1[3]);
            *(u32x4*)(U + rb + c) = w; }
    }
}

__device__ __forceinline__ void lora_prep(const bf16_t* PROJ, const float* mu, bf16_t* LA, int gtid, int nthr) {
    for (int it = gtid; it < TT * 48; it += nthr) {
        const int T = it / 48, g = it % 48, j0 = 8 * g;
        u32x4 o = (u32x4){0u, 0u, 0u, 0u};
        if (j0 < 288) {
            const bf16_t* cp = PROJ + (size_t)T * NP + C_RW + 3072 + j0;
            const u32x4 cur = *(const u32x4*)cp;
            u32x4 prv = (u32x4){0u, 0u, 0u, 0u};
            if ((T & (SEQ - 1)) != 0) prv = *(const u32x4*)(cp - NP);
            float fc[8], fp[8], r[8]; unpack8(cur, fc); unpack8(prv, fp);
            const f32x4 m0 = *(const f32x4*)(mu + 3072 + j0), m1 = *(const f32x4*)(mu + 3072 + j0 + 4);
#pragma unroll
            for (int e = 0; e < 8; ++e) { const float mm = e < 4 ? m0[e] : m1[e - 4]; const float zs = fc[e] + (fp[e] - fc[e]) * mm;
                r[e] = j0 < 64 ? (1.f - 2.f * __builtin_amdgcn_rcpf(__expf(2.f * zs) + 1.f)) : (j0 < 128 ? zs : sigmoidf_(zs)); }
            o = pack8(r);
        }
        *(u32x4*)(LA + (size_t)T * KLORA + j0) = o;
    }
}
__device__ __forceinline__ void fox_cumsum(const bf16_t* PROJ, const float* bforget, float* Carr, LAS unsigned char* lds, int bid, int G, int tid) {
    LAS float* wt = (LAS float*)lds; const int lane = tid & 63, wave = tid >> 6;
    for (int bh = bid; bh < 16; bh += G) {
        const int b = bh >> 2, h = bh & 3; const float bf = bforget[h];
        const bf16_t* src = PROJ + ((size_t)b * SEQ + 8 * tid) * NP + C_FB + h;
        float lf[8], loc = 0.f;
#pragma unroll
        for (int i = 0; i < 8; ++i) { const float x = bf1(src[(size_t)i * NP]) + bf; lf[i] = fminf(x, 0.f) - __logf(1.f + __expf(-fabsf(x))); loc += lf[i]; }
        float inc = loc;
#pragma unroll
        for (int o = 1; o < 64; o <<= 1) { const float y = __shfl_up(inc, o); if (lane >= o) inc += y; }
        if (lane == 63) wt[wave] = inc;
        __syncthreads();
        float run = inc - loc;
        for (int w2 = 0; w2 < wave; ++w2) run += wt[w2];
        float* dst = Carr + (size_t)bh * SEQ + 8 * tid;
#pragma unroll
        for (int i = 0; i < 8; ++i) { run += lf[i]; dst[i] = run; }
        __syncthreads();
    }
}
__device__ __forceinline__ void fox_kmax(const bf16_t* PROJ, unsigned* KM, int gw, int ngw, int lane) {
    const int bh = gw & 15, b = bh >> 2, h = bh & 3, nch = ngw >> 4; float mx = 0.f;
    if (nch == 0) return;
    for (int r = (gw >> 4) * 4; r < SEQ; r += nch * 4) {
        const int row = r + (lane >> 4); float f[8];
        unpack8(*(const u32x4*)(PROJ + ((size_t)b * SEQ + row) * NP + C_KB + h * 128 + (lane & 15) * 8), f);
        float s = 0.f;
#pragma unroll
        for (int e = 0; e < 8; ++e) s += f[e] * f[e];
        mx = fmaxf(mx, sum16(s));
    }
#pragma unroll
    for (int o = 1; o < 64; o <<= 1) mx = fmaxf(mx, __shfl_xor(mx, o));
    if (lane == 0) atomicMax(KM + bh, __float_as_uint(sqrtf(mx)));
}

namespace att {
constexpr int KROW = 272, VROW = 136, KT_BYTES = 64 * KROW, C_OFF = KT_BYTES + 128 * VROW, BUF = C_OFF + 256, FLAG_OFF = 2 * BUF;
constexpr float SCALE = 0.08838834764831845f;
template <int TYPE>
__device__ __forceinline__ void attn_item(LAS unsigned char* lds, const bf16_t* PROJ, const bf16_t* VTg, const float* cb, float kmax, bf16_t* Y, int b, int h, int qb) {
    int tid_ = threadIdx.x; asm volatile("" : "+v"(tid_));
    const int tid = tid_, w = __builtin_amdgcn_readfirstlane(tid >> 6), lane = tid & 63, q = lane & 31, hi = lane >> 5;
    const int q0 = qb * 256, qw0 = q0 + 32 * w, tq = qw0 + q;
    const int qcol = (TYPE == 0 ? C_QA : C_QB) + h * 128, kcol = qcol + 512;
    const size_t rowbase = (size_t)b * SEQ;
    bf16x8 qf[8];
    { const bf16_t* qp = PROJ + (rowbase + tq) * NP + qcol + 8 * hi;
#pragma unroll
      for (int ks = 0; ks < 8; ++ks) qf[ks] = *(const bf16x8*)(qp + 16 * ks); }
    float zb = 0.f;
    if (TYPE == 1) { float qn = 0.f;
#pragma unroll
        for (int ks = 0; ks < 8; ++ks) { float f[8]; unpack8(__builtin_bit_cast(u32x4, qf[ks]), f);
#pragma unroll
            for (int e = 0; e < 8; ++e) qn += f[e] * f[e]; }
        qn += __shfl_xor(qn, 32); zb = SCALE * sqrtf(qn) * kmax * 1.0001f; }
    f32x16 o[4];
#pragma unroll
    for (int d = 0; d < 4; ++d)
#pragma unroll
        for (int i = 0; i < 16; ++i) o[d][i] = 0.f;
    float m_run = -INFINITY, l_run = 0.f, R = 0.f;
    const int nkt = 4 * (qb + 1);
    const bf16_t* kg[2]; const bf16_t* vg[2]; int kl[2], vl[2];
#pragma unroll
    for (int i = 0; i < 2; ++i) { const int p = tid + 512 * i;
        kg[i] = PROJ + (rowbase + (p >> 4)) * NP + kcol + 8 * (p & 15); kl[i] = (p >> 4) * KROW + (p & 15) * 16;
        vg[i] = VTg + (size_t)((TYPE == 0 ? 0 : 512) + h * 128 + (p >> 3)) * TT + rowbase + 8 * (p & 7); vl[i] = KT_BYTES + (p >> 3) * VROW + (p & 7) * 16; }
    u32x4 kr[2], vr[2];
#pragma unroll
    for (int i = 0; i < 2; ++i) { kr[i] = *(const u32x4*)(kg[i] + (size_t)(nkt - 1) * 64 * NP); vr[i] = *(const u32x4*)(vg[i] + (nkt - 1) * 64); }
    f32x4 creg = (f32x4){0.f, 0.f, 0.f, 0.f};
    if (TYPE == 1 && tid < 16) creg = *(const f32x4*)(cb + (nkt - 1) * 64 + 4 * tid);
    LAS float* flags = (LAS float*)(lds + FLAG_OFF);
    for (int it = 0; it < nkt; ++it) {
        const int kt = nkt - 1 - it; LAS unsigned char* buf = lds + (it & 1) * BUF;
#pragma unroll
        for (int i = 0; i < 2; ++i) { *(LAS u32x4*)(buf + kl[i]) = kr[i]; *(LAS u32x2*)(buf + vl[i]) = (u32x2){vr[i].x, vr[i].y}; *(LAS u32x2*)(buf + vl[i] + 8) = (u32x2){vr[i].z, vr[i].w}; }
        if (TYPE == 1 && tid < 16) *(LAS f32x4*)(buf + C_OFF + 16 * tid) = creg;
        if (kt > 0) {
#pragma unroll
            for (int i = 0; i < 2; ++i) { kr[i] = *(const u32x4*)(kg[i] + (size_t)(kt - 1) * 64 * NP); vr[i] = *(const u32x4*)(vg[i] + (kt - 1) * 64); }
            if (TYPE == 1 && tid < 16) creg = *(const f32x4*)(cb + (kt - 1) * 64 + 4 * tid);
        }
        __syncthreads();
        if (it > 0) {
            float mx = flags[((it - 1) & 1) * 8];
#pragma unroll
            for (int j = 1; j < 8; ++j) mx = fmaxf(mx, flags[((it - 1) & 1) * 8 + j]);
            if (mx < -40.f) break;
        }
        if (64 * kt <= qw0 + 31) {
            f32x16 s[2];
#pragma unroll
            for (int kb = 0; kb < 2; ++kb) {
#pragma unroll
                for (int i = 0; i < 16; ++i) s[kb][i] = 0.f;
#pragma unroll
                for (int ks = 0; ks < 8; ++ks) { const bf16x8 a = *(const LAS bf16x8*)(buf + (32 * kb + q) * KROW + (16 * ks + 8 * hi) * 2);
                    s[kb] = __builtin_amdgcn_mfma_f32_32x32x16_bf16(a, qf[ks], s[kb], 0, 0, 0); }
            }
            const bool need_mask = (64 * kt + 63 >= qw0);
            bf16x8 pf[4];
            if (TYPE == 1) {
                float mloc = -INFINITY;
#pragma unroll
                for (int kb = 0; kb < 2; ++kb)
#pragma unroll
                    for (int g4 = 0; g4 < 4; ++g4) { const int sb = 64 * kt + 32 * kb + 8 * g4 + 4 * hi; const f32x4 c4 = *(const LAS f32x4*)(buf + C_OFF + (32 * kb + 8 * g4 + 4 * hi) * 4);
#pragma unroll
                        for (int e = 0; e < 4; ++e) { float z = s[kb][4 * g4 + e] * SCALE - c4[e]; if (need_mask && (sb + e > tq)) z = -INFINITY; s[kb][4 * g4 + e] = z; mloc = fmaxf(mloc, z); } }
                mloc = fmaxf(mloc, __shfl_xor(mloc, 32));
                const float m_new = fmaxf(m_run, mloc), alpha = __expf(m_run - m_new);
                float ls = 0.f;
#pragma unroll
                for (int kb = 0; kb < 2; ++kb)
#pragma unroll
                    for (int i = 0; i < 16; ++i) { const float pe = __expf(s[kb][i] - m_new); s[kb][i] = pe; ls += pe; }
                l_run = l_run * alpha + ls; m_run = m_new;
#pragma unroll
                for (int d = 0; d < 4; ++d)
#pragma unroll
                    for (int i = 0; i < 16; ++i) o[d][i] *= alpha;
            } else {
                float lr[2][16], gs[8], par[8];
#pragma unroll
                for (int kb = 0; kb < 2; ++kb)
#pragma unroll
                    for (int g4 = 0; g4 < 4; ++g4) { const int sb = 64 * kt + 32 * kb + 8 * g4 + 4 * hi; float sum = 0.f;
#pragma unroll
                        for (int e = 0; e < 4; ++e) { const float z = s[kb][4 * g4 + e] * SCALE; const float sp = __logf(1.f + __expf(-fabsf(z)));
                            const float lb = fminf(z, 0.f) - sp; const bool valid = !(need_mask && (sb + e >= tq));
                            const float l_ = valid ? (lb - z) : 0.f; lr[kb][4 * g4 + e] = l_; sum += l_;
                            s[kb][4 * g4 + e] = valid ? lb : -INFINITY; }
                        gs[4 * kb + g4] = sum; }
#pragma unroll
                for (int L = 0; L < 8; ++L) par[L] = __shfl_xor(gs[L], 32);
                float accO = 0.f, accP = 0.f;
#pragma unroll
                for (int L = 7; L >= 0; --L) { const int kb = L >> 2, g4 = L & 3;
                    float run = R + accO + accP + (hi == 0 ? par[L] : 0.f);
#pragma unroll
                    for (int e = 3; e >= 0; --e) { const float lb = s[kb][4 * g4 + e]; s[kb][4 * g4 + e] = __expf(lb + run); run += lr[kb][4 * g4 + e]; }
                    accO += gs[L]; accP += par[L]; }
                R += accO + accP;
            }
#pragma unroll
            for (int j = 0; j < 4; ++j) { const int kb = j >> 1, ib = 8 * (j & 1);
                u32x4 w; w.x = cvt_pk_bf16(s[kb][ib + 0], s[kb][ib + 1]); w.y = cvt_pk_bf16(s[kb][ib + 2], s[kb][ib + 3]); w.z = cvt_pk_bf16(s[kb][ib + 4], s[kb][ib + 5]); w.w = cvt_pk_bf16(s[kb][ib + 6], s[kb][ib + 7]);
                pf[j] = __builtin_bit_cast(bf16x8, w); }
#pragma unroll
            for (int d = 0; d < 4; ++d)
#pragma unroll
                for (int j = 0; j < 4; ++j) { const LAS unsigned char* vp = buf + KT_BYTES + (32 * d + q) * VROW + (16 * j + 4 * hi) * 2;
                    const u32x2 v0 = *(const LAS u32x2*)vp, v1 = *(const LAS u32x2*)(vp + 16);
                    const bf16x8 a = __builtin_bit_cast(bf16x8, (u32x4){v0.x, v0.y, v1.x, v1.y});
                    o[d] = __builtin_amdgcn_mfma_f32_32x32x16_bf16(a, pf[j], o[d], 0, 0, 0); }
        }
        { float rm = R;
            if (TYPE == 1) rm = zb - *(const LAS float*)(buf + C_OFF) - m_run;
#pragma unroll
            for (int o_ = 1; o_ < 32; o_ <<= 1) rm = fmaxf(rm, __shfl_xor(rm, o_));
            if (lane == 0) flags[(it & 1) * 8 + w] = rm; }
    }
    if (TYPE == 1) { const float lt = l_run + __shfl_xor(l_run, 32); const float inv = 1.0f / lt;
#pragma unroll
        for (int d = 0; d < 4; ++d)
#pragma unroll
            for (int i = 0; i < 16; ++i) o[d][i] *= inv; }
    bf16_t* yp = Y + (rowbase + tq) * 1024 + (TYPE == 0 ? 0 : 512) + h * 128 + 4 * hi;
#pragma unroll
    for (int d = 0; d < 4; ++d)
#pragma unroll
        for (int g4 = 0; g4 < 4; ++g4) { u32x2 w; w.x = cvt_pk_bf16(o[d][4 * g4], o[d][4 * g4 + 1]); w.y = cvt_pk_bf16(o[d][4 * g4 + 2], o[d][4 * g4 + 3]); *(u32x2*)(yp + 32 * d + 8 * g4) = w; }
    __syncthreads();
}
}

namespace rwkv {
typedef float f32x2 __attribute__((ext_vector_type(2)));
struct ChunkRegs { u32x4 zr, zk, zv, pr, pk, pv, e8, a8; };
constexpr int CH = 32;
constexpr int BUFF = 11392;
__device__ __forceinline__ void load_chunk(ChunkRegs& c, const bf16_t* PROJ, const bf16_t* LO, int b, int ci, int pt, int col) {
    const int s = ci * CH + pt; const size_t T = (size_t)b * SEQ + s;
    const bf16_t* rp = PROJ + T * NP + C_RW + col;
    c.zr = *(const u32x4*)rp; c.zk = *(const u32x4*)(rp + 1024); c.zv = *(const u32x4*)(rp + 2048);
    if (s > 0) { c.pr = *(const u32x4*)(rp - NP); c.pk = *(const u32x4*)(rp - NP + 1024); c.pv = *(const u32x4*)(rp - NP + 2048); }
    else { c.pr = (u32x4){0u, 0u, 0u, 0u}; c.pk = c.pr; c.pv = c.pr; }
    const bf16_t* lp = LO + T * NLORA + col;
    c.e8 = *(const u32x4*)lp; c.a8 = *(const u32x4*)(lp + 1024);
}
__device__ __forceinline__ void prep_chunk(const ChunkRegs& cr, LAS float* bufp, const LAS float* par, int pt, int pc, int qv, float* bonp) {
    float zr[8], zk[8], zv[8], qr[8], qk[8], qv_[8], e8[8], a8[8];
    unpack8(cr.zr, zr); unpack8(cr.zk, zk); unpack8(cr.zv, zv); unpack8(cr.pr, qr); unpack8(cr.pk, qk); unpack8(cr.pv, qv_); unpack8(cr.e8, e8); unpack8(cr.a8, a8);
    float kkr[8], kp[8], wv[8], rr[8], vv[8]; float n2 = 0.f;
#pragma unroll
    for (int e = 0; e < 8; ++e) {
        const float r = zr[e] + (qr[e] - zr[e]) * par[0 * 64 + pc + e];
        const float k = zk[e] + (qk[e] - zk[e]) * par[1 * 64 + pc + e];
        const float v = zv[e] + (qv_[e] - zv[e]) * par[2 * 64 + pc + e];
        wv[e] = __expf(e8[e]);
        rr[e] = r; vv[e] = v; kkr[e] = k * par[3 * 64 + pc + e]; n2 += kkr[e] * kkr[e];
        kp[e] = k * (1.f + (a8[e] - 1.f) * par[4 * 64 + pc + e]);
    }
    n2 = sum8(n2);
    const float inv = fminf(__builtin_amdgcn_rsqf(n2), 1e12f);
    float kr = 0.f, kkar = 0.f, bon = 0.f;
    float kk[8], kka[8], wr[8];
#pragma unroll
    for (int e = 0; e < 8; ++e) { kk[e] = kkr[e] * inv; kka[e] = kk[e] * a8[e]; wr[e] = wv[e] * rr[e];
        kr += kp[e] * rr[e]; kkar += kka[e] * rr[e]; bon += rr[e] * kp[e] * par[5 * 64 + pc + e]; }
    kr = sum8(kr); kkar = sum8(kkar); bon = sum8(bon);
    const int o = pt * 64 + pc;
    *(LAS f32x4*)(bufp + o) = (f32x4){kk[0], kk[1], kk[2], kk[3]}; *(LAS f32x4*)(bufp + o + 4) = (f32x4){kk[4], kk[5], kk[6], kk[7]};
    *(LAS f32x4*)(bufp + 2048 + o) = (f32x4){wr[0], wr[1], wr[2], wr[3]}; *(LAS f32x4*)(bufp + 2048 + o + 4) = (f32x4){wr[4], wr[5], wr[6], wr[7]};
    *(LAS f32x4*)(bufp + 4096 + o) = (f32x4){wv[0], wv[1], wv[2], wv[3]}; *(LAS f32x4*)(bufp + 4096 + o + 4) = (f32x4){wv[4], wv[5], wv[6], wv[7]};
    *(LAS f32x4*)(bufp + 6144 + o) = (f32x4){kp[0], kp[1], kp[2], kp[3]}; *(LAS f32x4*)(bufp + 6144 + o + 4) = (f32x4){kp[4], kp[5], kp[6], kp[7]};
    *(LAS f32x4*)(bufp + 8192 + o) = (f32x4){kka[0], kka[1], kka[2], kka[3]}; *(LAS f32x4*)(bufp + 8192 + o + 4) = (f32x4){kka[4], kka[5], kka[6], kka[7]};
    if ((pc >> 5) == qv) { LAS float* vp = bufp + 10240 + pt * 32 + (pc & 24);
        *(LAS f32x4*)vp = (f32x4){vv[0], vv[1], vv[2], vv[3]}; *(LAS f32x4*)(vp + 4) = (f32x4){vv[4], vv[5], vv[6], vv[7]}; }
    if (pc == 0) { *(LAS f32x2*)(bufp + 11264 + 2 * pt) = (f32x2){kr, kkar}; if (qv == 0) *bonp = bon; }
}
__device__ __forceinline__ void rwkv_item(LAS unsigned char* lds, int l, const bf16_t* PROJ, const bf16_t* LO, bf16_t* YR, float* BON, int b, int h, int qv) {
    LAS float* base = (LAS float*)lds; LAS float* yA = base + 2 * BUFF; LAS float* par = yA + 8192;
    int tid_ = threadIdx.x; asm volatile("" : "+v"(tid_));
    const int tid = tid_, w = __builtin_amdgcn_readfirstlane(tid >> 6), lane = tid & 63;
    {
        const int a = tid >> 6, ch = tid & 63, c = h * 64 + ch; float v;
        if (a == 0) v = arg_in(7)[(size_t)l * 3360 + c]; else if (a == 1) v = arg_in(7)[(size_t)l * 3360 + 1024 + c]; else if (a == 2) v = arg_in(7)[(size_t)l * 3360 + 2048 + c];
        else if (a == 3) v = arg_in(13)[(size_t)l * 1024 + c]; else if (a == 4) v = arg_in(14)[(size_t)l * 1024 + c]; else if (a == 5) v = arg_in(15)[(size_t)l * 1024 + c];
        else if (a == 6) v = arg_in(8)[(size_t)l * 1024 + c]; else v = arg_in(10)[(size_t)l * 1024 + c];
        par[a * 64 + ch] = v;
    }
    __syncthreads();
    constexpr int NCH = SEQ / CH;
    if (w >= 4) {
        const int ptid = tid & 255, pt = ptid >> 3, pc = (ptid & 7) * 8, col = h * 64 + pc;
        float* bonb = BON + ((size_t)b * SEQ + pt) * 16 + h;
        ChunkRegs cr, nx; load_chunk(cr, PROJ, LO, b, 0, pt, col);
        prep_chunk(cr, base, par, pt, pc, qv, bonb);
        load_chunk(cr, PROJ, LO, b, 1, pt, col);
        __syncthreads();
        for (int ci = 0; ci < NCH; ++ci) {
            if (ci + 2 < NCH) load_chunk(nx, PROJ, LO, b, ci + 2, pt, col); else nx = cr;
            if (ci >= 1 && ptid < 128) { const int t = ptid >> 2, q4 = ptid & 3; const LAS float* yp = yA + ((ci - 1) & 1) * 4096 + (t * 32 + 8 * q4) * 4;
                float yv[8];
#pragma unroll
                for (int r = 0; r < 8; ++r) { const f32x4 q = *(const LAS f32x4*)(yp + 4 * r); yv[r] = (q[0] + q[1]) + (q[2] + q[3]); }
                *(u32x4*)(YR + ((size_t)b * SEQ + (ci - 1) * CH + t) * 1024 + h * 64 + 32 * qv + 8 * q4) = pack8(yv); }
            if (ci + 1 < NCH) prep_chunk(cr, base + ((ci + 1) & 1) * BUFF, par, pt, pc, qv, bonb + (size_t)(ci + 1) * CH * 16);
            cr = nx;
            __syncthreads();
        }
        if (ptid < 128) { const int t = ptid >> 2, q4 = ptid & 3; const LAS float* yp = yA + ((NCH - 1) & 1) * 4096 + (t * 32 + 8 * q4) * 4;
            float yv[8];
#pragma unroll
            for (int r = 0; r < 8; ++r) { const f32x4 q = *(const LAS f32x4*)(yp + 4 * r); yv[r] = (q[0] + q[1]) + (q[2] + q[3]); }
            *(u32x4*)(YR + ((size_t)b * SEQ + (NCH - 1) * CH + t) * 1024 + h * 64 + 32 * qv + 8 * q4) = pack8(yv); }
    } else {
        __builtin_amdgcn_s_setprio(3);
        const int rl = 8 * w + (lane >> 4), kq = lane & 15;
        f32x2 S01[2], S23[2];
#pragma unroll
        for (int c = 0; c < 2; ++c) { S01[c] = (f32x2){0.f, 0.f}; S23[c] = (f32x2){0.f, 0.f}; }
        __syncthreads();
        for (int ci = 0; ci < NCH; ++ci) {
            const LAS float* pk = base + (ci & 1) * BUFF + 4 * kq; const LAS float* pv = base + (ci & 1) * BUFF + 10240 + rl; const LAS float* ps = base + (ci & 1) * BUFF + 11264;
            LAS float* py = yA + (ci & 1) * 4096 + rl * 4 + (kq >> 2);
            f32x4 kk4 = *(const LAS f32x4*)(pk), wr4 = *(const LAS f32x4*)(pk + 2048), w4 = *(const LAS f32x4*)(pk + 4096), k4 = *(const LAS f32x4*)(pk + 6144), a4 = *(const LAS f32x4*)(pk + 8192);
            float vv[2] = {pv[0], pv[4]}; f32x2 sc = *(const LAS f32x2*)(ps);
#pragma unroll 32
            for (int t = 0; t < CH; ++t) {
                const int tn = (t + 1) & (CH - 1);
                const LAS float* pn = pk + tn * 64;
                const f32x4 nkk = *(const LAS f32x4*)(pn), nwr = *(const LAS f32x4*)(pn + 2048), nw = *(const LAS f32x4*)(pn + 4096), nk = *(const LAS f32x4*)(pn + 6144), na = *(const LAS f32x4*)(pn + 8192);
                const float nv0 = pv[tn * 32], nv1 = pv[tn * 32 + 4]; const f32x2 nsc = *(const LAS f32x2*)(ps + 2 * tn);
                float sa[2], yp[2];
#pragma unroll
                for (int c = 0; c < 2; ++c) { const f32x2 pa = S23[c] * kk4.hi + S01[c] * kk4.lo, pb = S23[c] * wr4.hi + S01[c] * wr4.lo; sa[c] = pa.x + pa.y; yp[c] = pb.x + pb.y; }
#pragma unroll
                for (int c = 0; c < 2; ++c) { sa[c] = sum16(sa[c]); yp[c] += dppf<0xB1>(yp[c]); yp[c] += dppf<0x4E>(yp[c]); }
#pragma unroll
                for (int c = 0; c < 2; ++c) {
                    S01[c] = S01[c] * w4.lo + (k4.lo * vv[c] - a4.lo * sa[c]);
                    S23[c] = S23[c] * w4.hi + (k4.hi * vv[c] - a4.hi * sa[c]);
                    py[(t * 32 + 4 * c) * 4] = yp[c] + 0.25f * (vv[c] * sc.x - sa[c] * sc.y);
                }
                kk4 = nkk; wr4 = nwr; w4 = nw; k4 = nk; a4 = na; vv[0] = nv0; vv[1] = nv1; sc = nsc;
            }
            __syncthreads();
        }
        __builtin_amdgcn_s_setprio(0);
    }
    __syncthreads();
}
__device__ __forceinline__ void rwkv_post(int l, const bf16_t* PROJ, const bf16_t* LO, bf16_t* YR, const float* BON, int gtid, int nthr) {
    const float* mu = arg_in(7) + (size_t)l * 3360 + 2048; const float* lnw = arg_in(16) + (size_t)l * 1024; const float* lnb = arg_in(17) + (size_t)l * 1024;
    for (int it = gtid; it < TT * 128; it += nthr) {
        const int T = it >> 7, cgp = it & 127, c0 = 8 * cgp, h = cgp >> 3;
        float yv[8], zc[8], zp[8], gg[8];
        unpack8(*(const u32x4*)(YR + (size_t)T * 1024 + c0), yv);
        const bf16_t* vp = PROJ + (size_t)T * NP + C_RW + 2048 + c0;
        unpack8(*(const u32x4*)vp, zc);
        if ((T & (SEQ - 1)) != 0) unpack8(*(const u32x4*)(vp - NP), zp); else {
#pragma unroll
            for (int e = 0; e < 8; ++e) zp[e] = 0.f; }
        unpack8(*(const u32x4*)(LO + (size_t)T * NLORA + 2048 + c0), gg);
        float sm = 0.f;
#pragma unroll
        for (int e = 0; e < 8; ++e) sm += yv[e];
        const float mean = sum8(sm) * (1.0f / 64.0f);
        float sq = 0.f;
#pragma unroll
        for (int e = 0; e < 8; ++e) { const float d = yv[e] - mean; sq += d * d; }
        const float rstd = rsqrtf(sum8(sq) * (1.0f / 64.0f) + GN_EPS);
        const float bon = BON[(size_t)T * 16 + h];
        const f32x4 m0 = *(const f32x4*)(mu + c0), m1 = *(const f32x4*)(mu + c0 + 4), w0 = *(const f32x4*)(lnw + c0), w1 = *(const f32x4*)(lnw + c0 + 4), b0 = *(const f32x4*)(lnb + c0), b1 = *(const f32x4*)(lnb + c0 + 4);
        float out[8];
#pragma unroll
        for (int e = 0; e < 8; ++e) { const float mm = e < 4 ? m0[e] : m1[e - 4], ww = e < 4 ? w0[e] : w1[e - 4], bb = e < 4 ? b0[e] : b1[e - 4];
            const float v = zc[e] + (zp[e] - zc[e]) * mm; out[e] = ((yv[e] - mean) * rstd * ww + bb + bon * v) * gg[e]; }
        *(u32x4*)(YR + (size_t)T * 1024 + c0) = pack8(out);
    }
}
}


#define XB_TMO      128
#define XB_XCNT(j)  (256  + 64 * (j))
#define XB_XSUB(j)  (1280 + 64 * (j))
#define XB_XGEN(j)  (2304 + 64 * (j))
#define XB_TOP      3328
#define XB_TOPGEN   3392
#define XCD_BAR_WORDS 3456
#define XB_SPIN_CAP (1u << 22)
__device__ __forceinline__ unsigned xb_ld(unsigned* p)              { return __hip_atomic_load(p, __ATOMIC_RELAXED, __HIP_MEMORY_SCOPE_AGENT); }
__device__ __forceinline__ unsigned xb_add(unsigned* p, unsigned v) { return __hip_atomic_fetch_add(p, v, __ATOMIC_RELAXED, __HIP_MEMORY_SCOPE_AGENT); }
__device__ __forceinline__ unsigned xb_xcc_id() { return (unsigned)__builtin_amdgcn_s_getreg((3 << 11) | 20) & 0xFu; }
#define XB_SPIN(cond, bar) do { unsigned _sp = 0; while (cond) { __builtin_amdgcn_s_sleep(1); \
    if ((++_sp & 255u) == 0u) { if (xb_ld(&(bar)[XB_TMO])) break; if (_sp > XB_SPIN_CAP) { atomicAdd(&(bar)[XB_TMO], 1u); break; } } } } while (0)
struct XcdBarrier { unsigned* bar; unsigned x; volatile LAS unsigned* st; };
__device__ __forceinline__ XcdBarrier xcd_barrier_post(unsigned* bar, volatile LAS unsigned* st) {
    XcdBarrier b; b.bar = bar; b.x = xb_xcc_id(); b.st = st;
    if (threadIdx.x == 0) (void)xb_add(&bar[XB_XCNT(b.x)], 1u);
    return b;
}
__device__ __forceinline__ void xcd_barrier_complete(unsigned* bar, unsigned x, unsigned& nloc, unsigned& nx) {
    const unsigned G = gridDim.x * gridDim.y * gridDim.z;
    unsigned sum, cnt, mine, sp = 0u;
    for (;;) {
        sum = 0u; cnt = 0u; mine = 0u;
#pragma unroll
        for (unsigned j = 0; j < 16; ++j) { const unsigned c = xb_ld(&bar[XB_XCNT(j)]); sum += c; cnt += (c > 0u) ? 1u : 0u; mine = (j == x) ? c : mine; }
        if (sum == G) break;
        __builtin_amdgcn_s_sleep(1);
        if ((++sp & 255u) == 0u) { if (xb_ld(&bar[XB_TMO])) break; if (sp > XB_SPIN_CAP) { atomicAdd(&bar[XB_TMO], 1u); break; } }
    }
    nloc = mine > 0u ? mine : 1u; nx = cnt > 0u ? cnt : 1u;
}
__device__ __forceinline__ void xcd_barrier(const XcdBarrier& b) {
    asm volatile("s_waitcnt vmcnt(0)" ::: "memory");
    __syncthreads();
    if (threadIdx.x == 0) {
        unsigned* bar = b.bar;
        __builtin_amdgcn_s_waitcnt(0);
        unsigned nloc = b.st[0], nx = b.st[1];
        if (nloc == 0u) { xcd_barrier_complete(bar, b.x, nloc, nx); b.st[0] = nloc; b.st[1] = nx; }
        const unsigned old = xb_add(&bar[XB_XSUB(b.x)], 1u);
        const unsigned gen = old / nloc;
        if (old + 1u == (gen + 1u) * nloc) {
            __builtin_amdgcn_fence(__ATOMIC_RELEASE, "agent");
            asm volatile("s_waitcnt vmcnt(0)" ::: "memory");
            const unsigned og = xb_add(&bar[XB_TOP], 1u);
            const unsigned tg = og / nx;
            if (og + 1u == (tg + 1u) * nx) xb_add(&bar[XB_TOPGEN], 1u);
            else XB_SPIN(xb_ld(&bar[XB_TOPGEN]) == tg, bar);
            __builtin_amdgcn_fence(__ATOMIC_ACQUIRE, "agent");
            xb_add(&bar[XB_XGEN(b.x)], 1u);
            asm volatile("s_waitcnt vmcnt(0)" ::: "memory");
        } else {
            XB_SPIN(xb_ld(&bar[XB_XGEN(b.x)]) == gen, bar);
            __builtin_amdgcn_fence(__ATOMIC_ACQUIRE, "agent");
            asm volatile("s_waitcnt vmcnt(0)" ::: "memory");
        }
    }
    __syncthreads();
}

#ifndef PHASEMASK
#define PHASEMASK 63
#endif
#ifndef DUP_RWKV
#define DUP_RWKV 1
#endif
#ifndef DUP_ATT
#define DUP_ATT 1
#endif
#ifndef DUP_SYNC
#define DUP_SYNC 0
#endif
template <class T> __device__ __forceinline__ T* launder(T* q) { asm volatile("" : "+s"(q)); return q; }
#define WSP(off) ((bf16_t*)(arg_ws() + (off)))
__global__ void __launch_bounds__(512, 2) mega_fwd(Params p) {
    extern __shared__ __attribute__((aligned(16))) unsigned char lds_raw[];
    LAS unsigned char* lds = (LAS unsigned char*)lds_raw;
    cg::grid_group grid = cg::this_grid();
    const int G = gridDim.x, bid = blockIdx.x;
    volatile LAS unsigned* bst = (volatile LAS unsigned*)(lds + LDS_BYTES - 64);
    if (threadIdx.x < 2) bst[threadIdx.x] = 0u;
    __syncthreads();
    XcdBarrier xbar = xcd_barrier_post((unsigned*)arg_ws(), bst);
#define GSYNC() xcd_barrier(xbar)
#define TIDS int tid_ = threadIdx.x; asm volatile("" : "+v"(tid_)); const int tid = tid_, lane = tid & 63, wave = __builtin_amdgcn_readfirstlane(tid >> 6), gw = bid * 8 + wave, ngw = G * 8, gtid = bid * 512 + tid, nthr = G * 512; (void)lane; (void)gw; (void)ngw; (void)gtid; (void)nthr;

    { TIDS convert_weights(p, 0, lds, gw, ngw, wave, lane, gtid, nthr);
      norm_rows<false>(arg_in(0), nullptr, nullptr, nullptr, arg_in(1), WSP(WS_U), gw, ngw, lane); }
    grid.sync();
#pragma unroll 1
    for (int l = 0; l < 2; ++l) {
#if PHASEMASK & 1
        { pg8::Gemm g{WSP(WS_U), WSP(WS_WIN), TT, C_GATE, DM, DM, 0}; pg8::StaticOrder S; S.init(TT, C_GATE, G, bid);
          pg8::EpiStore<pg8::FProj> E{WSP(WS_BIG), NP, pg8::FProj{1 << 30}}; pg8::gemm_phase(lds, g, S, E); }
        { pg8::Gemm g{WSP(WS_WIN) + (size_t)NP * DM, WSP(WS_U), 1024, TT, DM, DM, 0}; pg8::StaticOrder S; S.init(1024, TT, G, bid);
          pg8::EpiStore<pg8::FProj> E{WSP(WS_VT), TT, pg8::FProj{1 << 30}}; pg8::gemm_phase(lds, g, S, E); }
        { pg8::Gemm g{WSP(WS_U), WSP(WS_WIN) + (size_t)C_GATE * DM, TT, GATE1, DM, DM, 0}; pg8::StaticOrder S; S.init(TT, GATE1, G, (bid + (G >> 1)) % G);
          pg8::EpiStore<pg8::FProj> E{WSP(WS_BIG) + C_GATE, NP, pg8::FProj{0}}; pg8::gemm_phase(lds, g, S, E); }
#endif
        GSYNC();
        { TIDS
          fox_cumsum(WSP(WS_BIG), arg_in(6) + (size_t)l * 4, (float*)WSP(WS_C), lds, bid, G, tid);
          lora_prep(WSP(WS_BIG), arg_in(7) + (size_t)l * 3360, WSP(WS_LA), gtid, nthr);
          fox_kmax(WSP(WS_BIG), (unsigned*)arg_ws() + 8192 + l * 16, gw, ngw, lane); }
        GSYNC();
#if PHASEMASK & 2
        { pg8::Gemm g{WSP(WS_LA), WSP(WS_WLORA), TT, NLORA, KLORA, KLORA, 0}; pg8::StaticOrder S; S.init(TT, NLORA, G, bid);
          pg8::EpiStore<pg8::FLora> E{WSP(WS_LO), NLORA, pg8::FLora{arg_in(8) + (size_t)l * 1024, arg_in(10) + (size_t)l * 1024}}; pg8::gemm_phase(lds, g, S, E); }
#endif
        GSYNC();
        {
            const int ra = G >> 1, na = G - ra;
#ifndef NO_RWKV
            if (bid < ra) for (int it = bid; it < 128; it += ra) rwkv::rwkv_item(lds, l, WSP(WS_BIG), WSP(WS_LO), WSP(WS_YR), (float*)WSP(WS_BON), it >> 5, (it >> 1) & 15, it & 1);
#endif
            if (bid >= ra) {
#ifndef NO_ATT
                for (int it = bid - ra; it < 512; it += na) {
                    if (it < 256) { const int qb = 15 - (it >> 4), bh = it & 15; att::attn_item<1>(lds, WSP(WS_BIG), WSP(WS_VT), (const float*)WSP(WS_C) + (size_t)bh * SEQ, __uint_as_float(((const unsigned*)arg_ws())[8192 + l * 16 + bh]), WSP(WS_YAB), bh >> 2, bh & 3, qb); }
                    else { const int j = it - 256; const int qb = 15 - (j >> 4), bh = j & 15; att::attn_item<0>(lds, WSP(WS_BIG), WSP(WS_VT), nullptr, 0.f, WSP(WS_YAB), bh >> 2, bh & 3, qb); }
                }
#endif
                { pg8::Gemm g{WSP(WS_U), WSP(WS_WIN) + (size_t)(C_GATE + GATE1) * DM, TT, GATE2, DM, DM, 0}; pg8::StaticOrder S; S.init(TT, GATE2, na, bid - ra);
                  pg8::EpiStore<pg8::FProj> E{WSP(WS_BIG) + C_GATE + GATE1, NP, pg8::FProj{0}}; pg8::gemm_phase(lds, g, S, E); }
            }
        }
        GSYNC();
        for (int rep = 0; rep < DUP_SYNC; ++rep) GSYNC();
        { TIDS rwkv::rwkv_post(l, WSP(WS_BIG), WSP(WS_LO), WSP(WS_YR), (const float*)WSP(WS_BON), gtid, nthr); }
        GSYNC();
#if PHASEMASK & 4
        { pg8::Gemm g{WSP(WS_YAB), WSP(WS_WBR), TT, DM, DM, 1024, (long)((long)WS_YR - (long)WS_YAB) - 2048L}; pg8::StaticOrder S; S.init(TT, DM, G, bid);
          pg8::EpiBranch E{WSP(WS_LO), WSP(WS_BIG) + C_GATE}; pg8::gemm_phase(lds, g, S, E); }
#endif
        GSYNC();
#if PHASEMASK & 8
        { pg8::Gemm g{WSP(WS_LO), WSP(WS_WOUT), TT, DM, DM, DM, 0}; pg8::StaticOrder S; S.init(TT, DM, G, bid);
          pg8::EpiStore<pg8::FId> E{WSP(WS_TMP), DM, pg8::FId{}}; pg8::gemm_phase(lds, g, S, E); }
#endif
        GSYNC();
        { TIDS const float* xin = (l == 0) ? arg_in(0) : (const float*)arg_out();
          norm_rows<true>(xin, WSP(WS_TMP), arg_in(2) + (size_t)l * DM, arg_out(), arg_in(3) + (size_t)l * DM, WSP(WS_U), gw, ngw, lane); }
        GSYNC();
#if PHASEMASK & 16
        { pg8::Gemm g{WSP(WS_U), WSP(WS_WUP), TT, FF, DM, DM, 0}; pg8::StaticOrder S; S.init(TT, FF, G, bid);
          pg8::EpiStore<pg8::FRelu2> E{WSP(WS_BIG), FF, pg8::FRelu2{}}; pg8::gemm_phase(lds, g, S, E); }
#endif
        GSYNC();
#if PHASEMASK & 32
        { pg8::Gemm g{WSP(WS_BIG), WSP(WS_WDN), TT, DM, FF, FF, 0}; pg8::StaticOrder S; S.init(TT, DM, G, bid);
          pg8::EpiStore<pg8::FId> E{WSP(WS_TMP), DM, pg8::FId{}}; pg8::gemm_phase(lds, g, S, E); }
#endif
        GSYNC();
        { TIDS norm_rows<true>(arg_out(), WSP(WS_TMP), arg_in(4) + (size_t)l * DM, arg_out(), (l == 0) ? arg_in(1) + DM : (const float*)nullptr, WSP(WS_U), gw, ngw, lane);
          if (l == 0) convert_weights(p, 1, lds, gw, ngw, wave, lane, gtid, nthr); }
        if (l == 0) GSYNC();
    }
}

extern "C" void kernel_launch(void* const* d_in, const int* in_sizes, int n_in, void* d_out, int out_size, void* d_ws, size_t ws_size, hipStream_t stream) {
    static int grid_blocks = 0;
    if (grid_blocks == 0) {
        if (n_in != 24 || ws_size < WS_END) { fprintf(stderr, "kernel_launch: unexpected n_in %d / ws %zu\n", n_in, ws_size); grid_blocks = -1; return; }
        int dev = 0, cus = 0, per_cu = 0;
        hipGetDevice(&dev);
        hipDeviceGetAttribute(&cus, hipDeviceAttributeMultiprocessorCount, dev);
        hipFuncSetAttribute((const void*)mega_fwd, hipFuncAttributeMaxDynamicSharedMemorySize, LDS_BYTES);
        hipOccupancyMaxActiveBlocksPerMultiprocessor(&per_cu, (const void*)mega_fwd, 512, LDS_BYTES);
        if (per_cu < 1) per_cu = 1;
        grid_blocks = cus * per_cu;
        (void)hipGetLastError();
    }
    if (grid_blocks < 0) return;
    if (hipMemsetAsync(d_ws, 0, 65536, stream) != hipSuccess) { fprintf(stderr, "memset failed\n"); return; }
    Params p{};
    for (int i = 0; i < 24; ++i) p.in[i] = (const float*)d_in[i];
    p.out = (float*)d_out; p.ws = (unsigned char*)d_ws;
    void* args[] = {&p};
    hipError_t e = hipLaunchCooperativeKernel((const void*)mega_fwd, dim3(grid_blocks), dim3(512), args, LDS_BYTES, stream);
    if (e != hipSuccess) fprintf(stderr, "cooperative launch failed: %s (grid %d)\n", hipGetErrorString(e), grid_blocks);
}
```

```cpp
#include <hip/hip_runtime.h>
#include <hip/hip_cooperative_groups.h>
#include <cstdio>
#include <cstdint>
namespace cg = cooperative_groups;

#define LAS __attribute__((address_space(3)))
typedef unsigned short bf16_t;
typedef short bf16x8 __attribute__((ext_vector_type(8)));
typedef float f32x4 __attribute__((ext_vector_type(4)));
typedef float f32x16 __attribute__((ext_vector_type(16)));
typedef unsigned u32x4 __attribute__((ext_vector_type(4)));
typedef unsigned u32x2 __attribute__((ext_vector_type(2)));

constexpr int TT = 16384;
constexpr int SEQ = 4096;
constexpr int DM = 2048;
constexpr int NP = 11776;
constexpr int NWIN = 12800;
constexpr int FF = 8192;
constexpr int C_QA = 0, C_KA = 512, C_QB = 1024, C_KB = 1536, C_RW = 2048, C_FB = 5408, C_GATE = 5632;
constexpr int NLORA = 3072, KLORA = 384;
constexpr int GATE1 = 512, GATE2 = 5632;
constexpr float RMS_EPS = 1e-6f, GN_EPS = 64e-5f;

constexpr size_t MiB = 1u << 20;
constexpr size_t WS_WIN = 1 * MiB, WS_WBR = 51 * MiB, WS_WOUT = 59 * MiB, WS_WUP = 67 * MiB, WS_WDN = 99 * MiB, WS_WLORA = 131 * MiB,
                 WS_C = 134 * MiB, WS_U = 135 * MiB, WS_BIG = 199 * MiB, WS_VT = 567 * MiB, WS_LA = 599 * MiB, WS_LO = 611 * MiB, WS_YR = 707 * MiB, WS_BON = 739 * MiB, WS_YAB = 740 * MiB, WS_END = 772 * MiB;
constexpr size_t WS_TMP = WS_BIG + 256 * MiB;
constexpr int LDS_BYTES = 147456;

struct Params { const float* in[24]; float* out; unsigned char* ws; };


#define AS4 __attribute__((address_space(4)))
__device__ __forceinline__ const float* arg_in(int k) { const char AS4* ka = (const char AS4*)__builtin_amdgcn_kernarg_segment_ptr(); asm volatile("" : "+s"(ka)); return *(const float* const AS4*)(ka + 8 * k); }
__device__ __forceinline__ float* arg_out() { const char AS4* ka = (const char AS4*)__builtin_amdgcn_kernarg_segment_ptr(); asm volatile("" : "+s"(ka)); return *(float* const AS4*)(ka + 192); }
__device__ __forceinline__ unsigned char* arg_ws() { const char AS4* ka = (const char AS4*)__builtin_amdgcn_kernarg_segment_ptr(); asm volatile("" : "+s"(ka)); return *(unsigned char* const AS4*)(ka + 200); }
__device__ __forceinline__ float bf_lo(unsigned u) { return __uint_as_float(u << 16); }
__device__ __forceinline__ float bf_hi(unsigned u) { return __uint_as_float(u & 0xffff0000u); }
__device__ __forceinline__ float bf1(bf16_t h) { return __uint_as_float(((unsigned)h) << 16); }
__device__ __forceinline__ unsigned cvt_pk_bf16(float lo, float hi) { unsigned r; asm volatile("v_cvt_pk_bf16_f32 %0, %1, %2" : "=v"(r) : "v"(lo), "v"(hi)); return r; }
__device__ __forceinline__ float sigmoidf_(float x) { return __builtin_amdgcn_rcpf(1.0f + __expf(-x)); }
template <int CTRL> __device__ __forceinline__ float dppf(float x) { return __builtin_bit_cast(float, __builtin_amdgcn_mov_dpp(__builtin_bit_cast(int, x), CTRL, 0xf, 0xf, true)); }
__device__ __forceinline__ float sum8(float x) { x += dppf<0xB1>(x); x += dppf<0x4E>(x); x += dppf<0x141>(x); return x; }
__device__ __forceinline__ float sum16(float x) { x += dppf<0xB1>(x); x += dppf<0x4E>(x); x += dppf<0x124>(x); x += dppf<0x128>(x); return x; }
__device__ __forceinline__ float xor16_sum(float x) { float a = x, b = x; asm volatile("s_nop 1\n\tv_permlane16_swap_b32 %0, %1\n\ts_nop 1" : "+v"(a), "+v"(b)); return a + b; }
__device__ __forceinline__ float sum32(float x) { return xor16_sum(sum16(x)); }
__device__ __forceinline__ float xor32_sum(float x) { float a = x, b = x; asm volatile("s_nop 1\n\tv_permlane32_swap_b32 %0, %1\n\ts_nop 1" : "+v"(a), "+v"(b)); return a + b; }
__device__ __forceinline__ float wave_sum(float v) { return xor32_sum(sum32(v)); }
__device__ __forceinline__ void unpack8(const u32x4 v, float (&f)[8]) {
    f[0] = bf_lo(v.x); f[1] = bf_hi(v.x); f[2] = bf_lo(v.y); f[3] = bf_hi(v.y); f[4] = bf_lo(v.z); f[5] = bf_hi(v.z); f[6] = bf_lo(v.w); f[7] = bf_hi(v.w);
}
__device__ __forceinline__ u32x4 pack8(const float (&f)[8]) {
    u32x4 w; w.x = cvt_pk_bf16(f[0], f[1]); w.y = cvt_pk_bf16(f[2], f[3]); w.z = cvt_pk_bf16(f[4], f[5]); w.w = cvt_pk_bf16(f[6], f[7]); return w;
}

namespace pg8 {
constexpr int BM = 256, BK = 64, HALF = 128, HTB = HALF * BK * 2, STAGE_BYTES = 8 * HTB, NXCD = 8, WGM = 8;
__device__ __forceinline__ int lds_byte(int r, int c) { const int st = (r >> 4) * 2 + (c >> 5), rr = r & 15, cc = c & 31, ob = rr * 64 + cc * 2; return st * 1024 + (ob ^ (((ob >> 9) & 1) << 5)); }
__device__ __forceinline__ void stage_rc(int b, int& R, int& C) { const int st = b / 1024, sb = b % 1024, swz = sb ^ (((sb >> 9) & 1) << 5); R = (st >> 1) * 16 + swz / 64; C = (st & 1) * 32 + (swz % 64) / 2; }
__device__ __forceinline__ int perm32(int rho) { const int n = rho >> 4, i = rho & 15; return 8 * (i >> 2) + 4 * n + (i & 3); }
struct Unit { int pm, pn; };
struct Gemm { const bf16_t* A; const bf16_t* Bt; int M, N, K; int lda; long ajump; };
struct StaticOrder {
    int nM, nN, nwg, G, c;
    __device__ void init(int M, int N, int G_, int c_) { nM = M / BM; nN = N / BM; nwg = nM * nN; G = G_; c = c_; }
    __device__ bool next(int i, Unit& u) const {
        const long L = (long)i * G + c; if (L >= nwg) return false;
        int wgid = (int)L; { const int q = nwg / NXCD, r = nwg % NXCD, xcd = wgid % NXCD, off = wgid / NXCD; wgid = (xcd < r ? xcd * (q + 1) : r * (q + 1) + (xcd - r) * q) + off; }
        const int nig = WGM * nN, gid = wgid / nig, fm = gid * WGM, gsz = (nM - fm) < WGM ? (nM - fm) : WGM;
        u.pm = fm + ((wgid % nig) % gsz); u.pn = (wgid % nig) / gsz; return true;
    }
};

template <class F> struct EpiStore {
    static constexpr bool PERM = true, GATED = false;
    bf16_t* O; int ldc; F f;
    __device__ __forceinline__ void rescale(f32x4 (&)[2][2][4][2], const Unit&, int, int, int, int, int) const {}
    __device__ __forceinline__ void operator()(f32x4 (&acc)[2][2][4][2], const Unit& u, int wr, int wc, int fr, int fq) const {
        int t2_ = threadIdx.x; asm volatile("" : "+v"(t2_)); (void)wr; (void)wc; (void)fr; (void)fq;
        const int row0 = u.pm * BM + ((t2_ >> 8) & 1) * 64 + (t2_ & 15), col0 = u.pn * BM + ((t2_ >> 6) & 3) * 32 + 8 * ((t2_ >> 4) & 3);
#pragma unroll
        for (int ai = 0; ai < 2; ++ai)
#pragma unroll
            for (int m = 0; m < 4; ++m) {
                bf16_t* rowp = O + (size_t)(row0 + ai * HALF + m * 16) * ldc + col0;
#pragma unroll
                for (int bj = 0; bj < 2; ++bj) {
                    f32x4 v0 = acc[ai][bj][m][0], v1 = acc[ai][bj][m][1];
                    f(v0, v1, u.pn, col0 + bj * HALF);
                    u32x4 w; w.x = cvt_pk_bf16(v0[0], v0[1]); w.y = cvt_pk_bf16(v0[2], v0[3]); w.z = cvt_pk_bf16(v1[0], v1[1]); w.w = cvt_pk_bf16(v1[2], v1[3]);
                    *(u32x4*)(rowp + bj * HALF) = w;
                }
            }
    }
};
struct FId { __device__ __forceinline__ void operator()(f32x4&, f32x4&, int, int) const {} };
struct FProj {
    int gate_pn;
    __device__ __forceinline__ void operator()(f32x4& a, f32x4& b, int pn, int) const {
        if (pn >= gate_pn) {
#pragma unroll
            for (int j = 0; j < 4; ++j) { a[j] = fmaxf(sigmoidf_(a[j]), 1e-18f); b[j] = fmaxf(sigmoidf_(b[j]), 1e-18f); }
        }
    }
};
struct FRelu2 { __device__ __forceinline__ void operator()(f32x4& a, f32x4& b, int, int) const {
#pragma unroll
        for (int j = 0; j < 4; ++j) { float x = fmaxf(a[j], 0.f); a[j] = x * x; float y = fmaxf(b[j], 0.f); b[j] = y * y; } } };
struct FLora {
    const float* w0; const float* a0;
    __device__ __forceinline__ void operator()(f32x4& a, f32x4& b, int pn, int col) const {
        if (pn < 8) {
            const float* pp = (pn < 4) ? (w0 + col) : (a0 + col - 1024);
            const float sc = (pn < 4) ? -0.6065306597126334f : 1.0f;
            const f32x4 p0 = *(const f32x4*)pp, p1 = *(const f32x4*)(pp + 4);
#pragma unroll
            for (int j = 0; j < 4; ++j) { a[j] = sc * sigmoidf_(a[j] + p0[j]); b[j] = sc * sigmoidf_(b[j] + p1[j]); }
        }
    }
};
struct EpiBranch {
    static constexpr bool PERM = true, GATED = true;
    bf16_t* O; const bf16_t* Gt;
    __device__ __forceinline__ void rescale(f32x4 (&acc)[2][2][4][2], const Unit& u, int seg, int wr, int wc, int fr, int fq) const {
        int t2_ = threadIdx.x; asm volatile("" : "+v"(t2_)); (void)wr; (void)wc; (void)fr; (void)fq;
        const int row0 = u.pm * BM + ((t2_ >> 8) & 1) * 64 + (t2_ & 15), col0 = u.pn * BM + ((t2_ >> 6) & 3) * 32 + 8 * ((t2_ >> 4) & 3);
#pragma unroll
        for (int ai = 0; ai < 2; ++ai)
#pragma unroll
            for (int m = 0; m < 4; ++m) {
                const bf16_t* gp = Gt + (size_t)(row0 + ai * HALF + m * 16) * NP + seg * 2048 + col0;
#pragma unroll
                for (int bj = 0; bj < 2; ++bj) {
                    const u32x4 ga = *(const u32x4*)(gp + bj * HALF), gb = *(const u32x4*)(gp + bj * HALF + 2048);
                    float fa[8], fb[8]; unpack8(ga, fa); unpack8(gb, fb);
#pragma unroll
                    for (int j = 0; j < 4; ++j) { acc[ai][bj][m][0][j] *= __fdividef(fa[j], fb[j]); acc[ai][bj][m][1][j] *= __fdividef(fa[4 + j], fb[4 + j]); }
                    asm volatile("" : "+v"(acc[ai][bj][m][0]), "+v"(acc[ai][bj][m][1]) :: "memory");
                }
            }
    }
    __device__ __forceinline__ void operator()(f32x4 (&acc)[2][2][4][2], const Unit& u, int wr, int wc, int fr, int fq) const {
        int t2_ = threadIdx.x; asm volatile("" : "+v"(t2_)); (void)wr; (void)wc; (void)fr; (void)fq;
        const int row0 = u.pm * BM + ((t2_ >> 8) & 1) * 64 + (t2_ & 15), col0 = u.pn * BM + ((t2_ >> 6) & 3) * 32 + 8 * ((t2_ >> 4) & 3);
#pragma unroll
        for (int ai = 0; ai < 2; ++ai)
#pragma unroll
            for (int m = 0; m < 4; ++m) {
                const size_t r = (size_t)(row0 + ai * HALF + m * 16);
#pragma unroll
                for (int bj = 0; bj < 2; ++bj) {
                    const u32x4 gc = *(const u32x4*)(Gt + r * NP + 4096 + col0 + bj * HALF);
                    float fc[8]; unpack8(gc, fc);
                    f32x4 v0 = acc[ai][bj][m][0], v1 = acc[ai][bj][m][1];
                    u32x4 w; w.x = cvt_pk_bf16(v0[0] * fc[0], v0[1] * fc[1]); w.y = cvt_pk_bf16(v0[2] * fc[2], v0[3] * fc[3]);
                    w.z = cvt_pk_bf16(v1[0] * fc[4], v1[1] * fc[5]); w.w = cvt_pk_bf16(v1[2] * fc[6], v1[3] * fc[7]);
                    *(u32x4*)(O + r * DM + col0 + bj * HALF) = w;
                    asm volatile("" ::: "memory");
                }
            }
    }
};

template <class Epi>
__device__ __forceinline__ void gemm_phase(LAS unsigned char* lds, const Gemm g, const StaticOrder& S, const Epi& E) {
    int tid_ = threadIdx.x; asm volatile("" : "+v"(tid_));
    const int tid = tid_, wid = __builtin_amdgcn_readfirstlane(tid >> 6), lane = tid & 63, wr = wid >> 2, wc = wid & 3, fr = lane & 15, fq = lane >> 4;
    const int K = g.K, nt = K / BK;
    unsigned voffA[2], voffB[2];
#pragma unroll
    for (int i = 0; i < 2; ++i) { int R, C; stage_rc(tid * 16 + i * 8192, R, C); const int Rb = Epi::PERM ? ((R & ~31) + perm32(R & 31)) : R;
        voffA[i] = (unsigned)(R * g.lda + C) * 2u; voffB[i] = (unsigned)(Rb * K + C) * 2u; }
    const size_t kstep = (size_t)(BK * 2);
    const size_t hstep = (size_t)HALF * K * 2;
    const size_t tstep = 2 * hstep;
    const size_t hstepA = (size_t)HALF * g.lda * 2, tstepA = 2 * hstepA;
    const long aj = g.ajump;
#define PG8_AP(base, tt) ((base) + (size_t)(tt) * kstep + (((tt) >= 16) ? aj : 0L))
    const unsigned ldsw = (unsigned)wid * 1024u;
    const int aoff = lds_byte(wr * 64 + fr, fq * 8), boff = lds_byte(wc * 32 + fr, fq * 8);
#define PG8_SA(b, h) (((b) * 2 + (h)) * HTB)
#define PG8_SB(b, h) ((4 + (b) * 2 + (h)) * HTB)
#define PG8_STAGE(bufoff, gbase, voff) do { _Pragma("unroll") for (int _i = 0; _i < 2; ++_i) \
        __builtin_amdgcn_global_load_lds((const unsigned*)((const char*)(gbase) + (voff)[_i]), (LAS unsigned*)(lds + (bufoff) + ldsw + _i * 8192), 16, 0, 0); } while (0)
#define PG8_LDA(dst, b, h) do { _Pragma("unroll") for (int m = 0; m < 4; ++m) _Pragma("unroll") for (int k = 0; k < 2; ++k) dst[m][k] = *(const LAS bf16x8*)(lds + PG8_SA(b, h) + aoff + m * 2048 + k * 1024); } while (0)
#define PG8_LDB(dst, b, h) do { _Pragma("unroll") for (int n = 0; n < 2; ++n) _Pragma("unroll") for (int k = 0; k < 2; ++k) dst[n][k] = *(const LAS bf16x8*)(lds + PG8_SB(b, h) + boff + n * 2048 + k * 1024); } while (0)
#define PG8_MMA(ai, bj, At, Bt) do { __builtin_amdgcn_s_setprio(1); _Pragma("unroll") for (int m = 0; m < 4; ++m) _Pragma("unroll") for (int n = 0; n < 2; ++n) _Pragma("unroll") for (int k = 0; k < 2; ++k) \
        acc[ai][bj][m][n] = __builtin_amdgcn_mfma_f32_16x16x32_bf16(Bt[n][k], At[m][k], acc[ai][bj][m][n], 0, 0, 0); __builtin_amdgcn_s_setprio(0); } while (0)
#define PG8_WAIT_V(n) asm volatile("s_waitcnt vmcnt(" #n ")" ::: "memory")
#define PG8_WAIT_L(n) asm volatile("s_waitcnt lgkmcnt(" #n ")" ::: "memory")
#define PG8_BAR __builtin_amdgcn_s_barrier()
#define PG8_SCHED __builtin_amdgcn_sched_barrier(0)
    Unit cur, nxt; int ui = 0;
    if (!S.next(0, cur)) return;
    f32x4 acc[2][2][4][2];
#pragma unroll
    for (int a = 0; a < 2; ++a)
#pragma unroll
        for (int b = 0; b < 2; ++b)
#pragma unroll
            for (int m = 0; m < 4; ++m)
#pragma unroll
                for (int n = 0; n < 2; ++n) acc[a][b][m][n] = (f32x4){0.f, 0.f, 0.f, 0.f};
    bf16x8 At[4][2], B0[2][2], B1[2][2];
    const char* cA = (const char*)g.A + (size_t)cur.pm * tstepA; const char* cB = (const char*)g.Bt + (size_t)cur.pn * tstep;
    PG8_STAGE(PG8_SB(0, 0), cB, voffB); PG8_STAGE(PG8_SB(0, 1), cB + hstep, voffB); PG8_STAGE(PG8_SA(0, 0), cA, voffA); PG8_STAGE(PG8_SA(0, 1), cA + hstepA, voffA);
    if (wr == 1) PG8_BAR;
    PG8_WAIT_V(2); PG8_BAR;
    PG8_STAGE(PG8_SB(1, 0), cB + kstep, voffB); PG8_STAGE(PG8_SA(1, 0), cA + kstep, voffA); PG8_STAGE(PG8_SB(1, 1), cB + hstep + kstep, voffB);
    PG8_WAIT_V(6); PG8_BAR;
    for (;;) {
        const bool has_next = S.next(ui + 1, nxt);
        const char* nA = has_next ? (const char*)g.A + (size_t)nxt.pm * tstepA : cA; const char* nB = has_next ? (const char*)g.Bt + (size_t)nxt.pn * tstep : cB;
#pragma unroll 1
        for (int t = 0; t < nt; t += 2) {
            if constexpr (Epi::GATED) { if (t == 8 || t == 16) E.rescale(acc, cur, t == 8 ? 0 : 1, wr, wc, fr, fq); }
            const bool last = (t == nt - 2);
            const char* a1 = PG8_AP(cA, t + 1);
            const char* a2 = last ? nA : PG8_AP(cA, t + 2); const char* b2 = last ? nB : cB + (size_t)(t + 2) * kstep;
            const char* a3 = last ? nA + kstep : PG8_AP(cA, t + 3); const char* b3 = b2 + kstep;
            PG8_LDB(B0, 0, 0); PG8_LDB(B1, 0, 1); PG8_SCHED; PG8_LDA(At, 0, 0); PG8_STAGE(PG8_SA(1, 1), a1 + hstepA, voffA);
            PG8_WAIT_V(8); PG8_WAIT_L(0); PG8_BAR; PG8_MMA(0, 0, At, B0); PG8_MMA(0, 1, At, B1); PG8_BAR; PG8_SCHED;
            PG8_LDA(At, 0, 1); PG8_STAGE(PG8_SB(0, 0), b2, voffB); PG8_STAGE(PG8_SB(0, 1), b2 + hstep, voffB); PG8_STAGE(PG8_SA(0, 0), a2, voffA);
            PG8_WAIT_V(8); PG8_WAIT_L(0); PG8_BAR; PG8_MMA(1, 0, At, B0); PG8_MMA(1, 1, At, B1); PG8_BAR; PG8_SCHED;
            PG8_LDB(B0, 1, 0); PG8_LDB(B1, 1, 1); PG8_SCHED; PG8_LDA(At, 1, 0); PG8_STAGE(PG8_SA(0, 1), a2 + hstepA, voffA);
            PG8_WAIT_V(8); PG8_WAIT_L(0); PG8_BAR; PG8_MMA(0, 0, At, B0); PG8_MMA(0, 1, At, B1); PG8_BAR; PG8_SCHED;
            PG8_LDA(At, 1, 1); PG8_STAGE(PG8_SB(1, 0), b3, voffB); PG8_STAGE(PG8_SB(1, 1), b3 + hstep, voffB); PG8_STAGE(PG8_SA(1, 0), a3, voffA);
            PG8_WAIT_V(8); PG8_WAIT_L(0); PG8_BAR; PG8_MMA(1, 0, At, B0); PG8_MMA(1, 1, At, B1); PG8_BAR; PG8_SCHED;
        }
        if (wr == 0) PG8_BAR;
        E(acc, cur, wr, wc, fr, fq);
        if (!has_next) break;
#pragma unroll
        for (int a = 0; a < 2; ++a)
#pragma unroll
            for (int b = 0; b < 2; ++b)
#pragma unroll
                for (int m = 0; m < 4; ++m)
#pragma unroll
                    for (int n = 0; n < 2; ++n) acc[a][b][m][n] = (f32x4){0.f, 0.f, 0.f, 0.f};
        cur = nxt; cA = nA; cB = nB; ++ui;
        if (wr == 1) PG8_BAR;
    }
    PG8_WAIT_V(0);
    PG8_BAR;
#undef PG8_AP
#undef PG8_SA
#undef PG8_SB
#undef PG8_STAGE
#undef PG8_LDA
#undef PG8_LDB
#undef PG8_MMA
#undef PG8_WAIT_V
#undef PG8_WAIT_L
#undef PG8_BAR
#undef PG8_SCHED
}
}

__device__ __forceinline__ int win_src(int n) {
    if (n < 1024) return n;
    if (n < 1536) return 1536 + (n - 1024);
    if (n < 2048) return 2048 + (n - 1536);
    if (n < 5408) return 3076 + (n - 2048);
    if (n < 5412) return 3072 + (n - 5408);
    if (n < 5632) return -1;
    if (n < 11776) return 6436 + (n - 5632);
    if (n < 12288) return 1024 + (n - 11776);
    return 2560 + (n - 12288);
}
__device__ __forceinline__ void tr_item(const float* W, int N, bf16_t* WT, int ldk, int koff, int k0, int nd0, int nsrc4, LAS float* scr, int lane) {
#pragma unroll 8
    for (int i = 0; i < 16; ++i) { const int kk = 4 * i + (lane >> 4);
        const f32x4 v = nsrc4 >= 0 ? *(const f32x4*)(W + (size_t)(k0 + kk) * N + nsrc4) : (f32x4){0.f, 0.f, 0.f, 0.f};
        *(LAS f32x4*)(scr + kk * 68 + ((4 * (lane & 15)) ^ (8 * ((kk >> 3) & 7)))) = v; }
    asm volatile("s_waitcnt lgkmcnt(0)" ::: "memory");
    const int c = lane & 7;
#pragma unroll
    for (int j = 0; j < 8; ++j) { const int n = (lane >> 3) + 8 * j; const LAS float* s = scr + (8 * c) * 68 + (n ^ (8 * c));
        u32x4 o; o.x = cvt_pk_bf16(s[0 * 68], s[1 * 68]); o.y = cvt_pk_bf16(s[2 * 68], s[3 * 68]); o.z = cvt_pk_bf16(s[4 * 68], s[5 * 68]); o.w = cvt_pk_bf16(s[6 * 68], s[7 * 68]);
        *(u32x4*)(WT + (size_t)(nd0 + n) * ldk + koff + k0 + 8 * c) = o; }
    asm volatile("s_waitcnt lgkmcnt(0)" ::: "memory");
}
__device__ __forceinline__ void convert_weights(const Params& p, int l, LAS unsigned char* lds, int gw, int ngw, int wave, int lane, int gtid, int nthr) {
    LAS float* scr = (LAS float*)(lds + wave * 17408);
    unsigned char* ws = arg_ws();
    bf16_t* WIN = (bf16_t*)(ws + WS_WIN); bf16_t* WBR = (bf16_t*)(ws + WS_WBR); bf16_t* WOUT = (bf16_t*)(ws + WS_WOUT);
    bf16_t* WUP = (bf16_t*)(ws + WS_WUP); bf16_t* WDN = (bf16_t*)(ws + WS_WDN); bf16_t* WLO = (bf16_t*)(ws + WS_WLORA);
    const float* w_in = arg_in(5) + (size_t)l * DM * 12580;
    const float* wba = arg_in(18) + (size_t)l * 512 * DM; const float* wbb = arg_in(19) + (size_t)l * 512 * DM; const float* wbc = arg_in(20) + (size_t)l * 1024 * DM;
    const float* wout = arg_in(21) + (size_t)l * DM * DM; const float* wup = arg_in(22) + (size_t)l * DM * FF; const float* wdn = arg_in(23) + (size_t)l * FF * DM;
    constexpr int I_IN = 32 * 200, I_BA = 8 * 32, I_BC = 16 * 32, I_OUT = 32 * 32, I_UP = 32 * 128, I_DN = 128 * 32;
    constexpr int NIT = I_IN + 2 * I_BA + I_BC + I_OUT + I_UP + I_DN;
    const int n4 = 4 * (lane & 15);
    for (int it = gw; it < NIT; it += ngw) {
        int r = it;
        if (r < I_IN) { const int kb = r / 200, nb = r % 200; tr_item(w_in, 12580, WIN, DM, 0, 64 * kb, 64 * nb, win_src(64 * nb + n4), scr, lane); continue; } r -= I_IN;
        if (r < I_BA) { const int kb = r / 32, nb = r % 32; tr_item(wba, DM, WBR, DM, 0, 64 * kb, 64 * nb, 64 * nb + n4, scr, lane); continue; } r -= I_BA;
        if (r < I_BA) { const int kb = r / 32, nb = r % 32; tr_item(wbb, DM, WBR, DM, 512, 64 * kb, 64 * nb, 64 * nb + n4, scr, lane); continue; } r -= I_BA;
        if (r < I_BC) { const int kb = r / 32, nb = r % 32; tr_item(wbc, DM, WBR, DM, 1024, 64 * kb, 64 * nb, 64 * nb + n4, scr, lane); continue; } r -= I_BC;
        if (r < I_OUT) { const int kb = r / 32, nb = r % 32; tr_item(wout, DM, WOUT, DM, 0, 64 * kb, 64 * nb, 64 * nb + n4, scr, lane); continue; } r -= I_OUT;
        if (r < I_UP) { const int kb = r / 128, nb = r % 128; tr_item(wup, FF, WUP, DM, 0, 64 * kb, 64 * nb, 64 * nb + n4, scr, lane); continue; } r -= I_UP;
        { const int kb = r / 32, nb = r % 32; tr_item(wdn, DM, WDN, FF, 0, 64 * kb, 64 * nb, 64 * nb + n4, scr, lane); }
    }
    const float* w_up = arg_in(9) + (size_t)l * 64 * 1024; const float* a_up = arg_in(11) + (size_t)l * 64 * 1024; const float* g_up = arg_in(12) + (size_t)l * 160 * 1024;
    for (int it = gtid; it < NLORA * (KLORA / 8); it += nthr) {
        const int n = it % NLORA, kc = it / NLORA, k0 = 8 * kc;
        float v[8];
#pragma unroll
        for (int e = 0; e < 8; ++e) { const int k = k0 + e; float x = 0.f;
            if (n < 1024) { if (k < 64) x = w_up[(size_t)k * 1024 + n]; }
            else if (n < 2048) { if (k >= 64 && k < 128) x = a_up[(size_t)(k - 64) * 1024 + (n - 1024)]; }
            else { if (k >= 128 && k < 288) x = g_up[(size_t)(k - 128) * 1024 + (n - 2048)]; }
            v[e] = x; }
        *(u32x4*)(WLO + (size_t)n * KLORA + k0) = pack8(v);
    }
}

template <bool HAS_T>
__device__ __forceinline__ void norm_rows(const float* xin, const bf16_t* t, const float* gpost, float* xout, const float* gpre, bf16_t* U, int gw, int ngw, int lane) {
    f32x4 xa[4][2], xn[4][2]; u32x4 tv[4], tn[4];
    if (gw < TT) {
        const size_t rb = (size_t)gw * DM;
#pragma unroll
        for (int j = 0; j < 4; ++j) { const int c = j * 512 + lane * 8; xn[j][0] = *(const f32x4*)(xin + rb + c); xn[j][1] = *(const f32x4*)(xin + rb + c + 4);
            if constexpr (HAS_T) tn[j] = *(const u32x4*)(t + rb + c); }
    }
    for (int m = gw; m < TT; m += ngw) {
        const size_t rb = (size_t)m * DM;
#pragma unroll
        for (int j = 0; j < 4; ++j) { xa[j][0] = xn[j][0]; xa[j][1] = xn[j][1]; if constexpr (HAS_T) tv[j] = tn[j]; }
        if (m + ngw < TT) {
            const size_t rn = (size_t)(m + ngw) * DM;
#pragma unroll
            for (int j = 0; j < 4; ++j) { const int c = j * 512 + lane * 8; xn[j][0] = *(const f32x4*)(xin + rn + c); xn[j][1] = *(const f32x4*)(xin + rn + c + 4);
                if constexpr (HAS_T) tn[j] = *(const u32x4*)(t + rn + c); }
        }
        if constexpr (HAS_T) {
            float ss = 0.f;
#pragma unroll
            for (int j = 0; j < 4; ++j) { float f[8]; unpack8(tv[j], f);
#pragma unroll
                for (int e = 0; e < 8; ++e) ss += f[e] * f[e]; }
            ss = wave_sum(ss);
            const float rs = rsqrtf(ss * (1.0f / DM) + RMS_EPS);
#pragma unroll
            for (int j = 0; j < 4; ++j) { const int c = j * 512 + lane * 8; float f[8]; unpack8(tv[j], f);
                const f32x4 g0 = *(const f32x4*)(gpost + c), g1 = *(const f32x4*)(gpost + c + 4);
#pragma unroll
                for (int e = 0; e < 4; ++e) { xa[j][0][e] += f[e] * rs * g0[e]; xa[j][1][e] += f[4 + e] * rs * g1[e]; }
                *(f32x4*)(xout + rb + c) = xa[j][0]; *(f32x4*)(xout + rb + c + 4) = xa[j][1]; }
        }
        if (gpre == nullptr) continue;
        float s2 = 0.f;
#pragma unroll
        for (int j = 0; j < 4; ++j)
#pragma unroll
            for (int e = 0; e < 4; ++e) s2 += xa[j][0][e] * xa[j][0][e] + xa[j][1][e] * xa[j][1][e];
        s2 = wave_sum(s2);
        const float r2 = rsqrtf(s2 * (1.0f / DM) + RMS_EPS);
#pragma unroll
        for (int j = 0; j < 4; ++j) { const int c = j * 512 + lane * 8;
            const f32x4 g0 = *(const f32x4*)(gpre + c), g1 = *(const f32x4*)(gpre + c + 4);
            u32x4 w; w.x = cvt_pk_bf16(xa[j][0][0] * r2 * g0[0], xa[j][0][1] * r2 * g0[1]); w.y = cvt_pk_bf16(xa[j][0][2] * r2 * g0[2], xa[j][0][3] * r2 * g0[3]);
            w.z = cvt_pk_bf16(xa[j][1][0] * r2 * g1[0], xa[j][1][1] * r2 * g1[1]); w.w = cvt_pk_bf16(xa[j][1][2] * r2 * g1[2], xa[j][1][3] * r2 * g1[3]);
            *(u32x4*)(U + rb + c) = w; }
    }
}

__device__ __forceinline__ void lora_prep(const bf16_t* PROJ, const float* mu, bf16_t* LA, int gtid, int nthr) {
    for (int it = gtid; it < TT * 48; it += nthr) {
        const int T = it / 48, g = it % 48, j0 = 8 * g;
        u32x4 o = (u32x4){0u, 0u, 0u, 0u};
        if (j0 < 288) {
            const bf16_t* cp = PROJ + (size_t)T * NP + C_RW + 3072 + j0;
            const u32x4 cur = *(const u32x4*)cp;
            u32x4 prv = (u32x4){0u, 0u, 0u, 0u};
            if ((T & (SEQ - 1)) != 0) prv = *(const u32x4*)(cp - NP);
            float fc[8], fp[8], r[8]; unpack8(cur, fc); unpack8(prv, fp);
            const f32x4 m0 = *(const f32x4*)(mu + 3072 + j0), m1 = *(const f32x4*)(mu + 3072 + j0 + 4);
#pragma unroll
            for (int e = 0; e < 8; ++e) { const float mm = e < 4 ? m0[e] : m1[e - 4]; const float zs = fc[e] + (fp[e] - fc[e]) * mm;
                r[e] = j0 < 64 ? (1.f - 2.f * __builtin_amdgcn_rcpf(__expf(2.f * zs) + 1.f)) : (j0 < 128 ? zs : sigmoidf_(zs)); }
            o = pack8(r);
        }
        *(u32x4*)(LA + (size_t)T * KLORA + j0) = o;
    }
}
__device__ __forceinline__ void fox_cumsum(const bf16_t* PROJ, const float* bforget, float* Carr, LAS unsigned char* lds, int bid, int G, int tid) {
    LAS float* wt = (LAS float*)lds; const int lane = tid & 63, wave = tid >> 6;
    for (int bh = bid; bh < 16; bh += G) {
        const int b = bh >> 2, h = bh & 3; const float bf = bforget[h];
        const bf16_t* src = PROJ + ((size_t)b * SEQ + 8 * tid) * NP + C_FB + h;
        float lf[8], loc = 0.f;
#pragma unroll
        for (int i = 0; i < 8; ++i) { const float x = bf1(src[(size_t)i * NP]) + bf; lf[i] = fminf(x, 0.f) - __logf(1.f + __expf(-fabsf(x))); loc += lf[i]; }
        float inc = loc;
#pragma unroll
        for (int o = 1; o < 64; o <<= 1) { const float y = __shfl_up(inc, o); if (lane >= o) inc += y; }
        if (lane == 63) wt[wave] = inc;
        __syncthreads();
        float run = inc - loc;
        for (int w2 = 0; w2 < wave; ++w2) run += wt[w2];
        float* dst = Carr + (size_t)bh * SEQ + 8 * tid;
#pragma unroll
        for (int i = 0; i < 8; ++i) { run += lf[i]; dst[i] = run; }
        __syncthreads();
    }
}
__device__ __forceinline__ void fox_kmax(const bf16_t* PROJ, unsigned* KM, int gw, int ngw, int lane) {
    const int bh = gw & 15, b = bh >> 2, h = bh & 3, nch = ngw >> 4; float mx = 0.f;
    if (nch == 0) return;
    for (int r = (gw >> 4) * 4; r < SEQ; r += nch * 4) {
        const int row = r + (lane >> 4); float f[8];
        unpack8(*(const u32x4*)(PROJ + ((size_t)b * SEQ + row) * NP + C_KB + h * 128 + (lane & 15) * 8), f);
        float s = 0.f;
#pragma unroll
        for (int e = 0; e < 8; ++e) s += f[e] * f[e];
        mx = fmaxf(mx, sum16(s));
    }
#pragma unroll
    for (int o = 1; o < 64; o <<= 1) mx = fmaxf(mx, __shfl_xor(mx, o));
    if (lane == 0) atomicMax(KM + bh, __float_as_uint(sqrtf(mx)));
}

namespace att {
constexpr int KROW = 272, VROW = 136, KT_BYTES = 64 * KROW, C_OFF = KT_BYTES + 128 * VROW, BUF = C_OFF + 256, FLAG_OFF = 2 * BUF;
constexpr float SCALE = 0.08838834764831845f;
template <int TYPE>
__device__ __forceinline__ void attn_item(LAS unsigned char* lds, const bf16_t* PROJ, const bf16_t* VTg, const float* cb, float kmax, bf16_t* Y, int b, int h, int qb) {
    int tid_ = threadIdx.x; asm volatile("" : "+v"(tid_));
    const int tid = tid_, w = __builtin_amdgcn_readfirstlane(tid >> 6), lane = tid & 63, q = lane & 31, hi = lane >> 5;
    const int q0 = qb * 256, qw0 = q0 + 32 * w, tq = qw0 + q;
    const int qcol = (TYPE == 0 ? C_QA : C_QB) + h * 128, kcol = qcol + 512;
    const size_t rowbase = (size_t)b * SEQ;
    bf16x8 qf[8];
    { const bf16_t* qp = PROJ + (rowbase + tq) * NP + qcol + 8 * hi;
#pragma unroll
      for (int ks = 0; ks < 8; ++ks) qf[ks] = *(const bf16x8*)(qp + 16 * ks); }
    float zb = 0.f;
    if (TYPE == 1) { float qn = 0.f;
#pragma unroll
        for (int ks = 0; ks < 8; ++ks) { float f[8]; unpack8(__builtin_bit_cast(u32x4, qf[ks]), f);
#pragma unroll
            for (int e = 0; e < 8; ++e) qn += f[e] * f[e]; }
        qn += __shfl_xor(qn, 32); zb = SCALE * sqrtf(qn) * kmax * 1.0001f; }
    f32x16 o[4];
#pragma unroll
    for (int d = 0; d < 4; ++d)
#pragma unroll
        for (int i = 0; i < 16; ++i) o[d][i] = 0.f;
    float m_run = -INFINITY, l_run = 0.f, R = 0.f;
    const int nkt = 4 * (qb + 1);
    const bf16_t* kg[2]; const bf16_t* vg[2]; int kl[2], vl[2];
#pragma unroll
    for (int i = 0; i < 2; ++i) { const int p = tid + 512 * i;
        kg[i] = PROJ + (rowbase + (p >> 4)) * NP + kcol + 8 * (p & 15); kl[i] = (p >> 4) * KROW + (p & 15) * 16;
        vg[i] = VTg + (size_t)((TYPE == 0 ? 0 : 512) + h * 128 + (p >> 3)) * TT + rowbase + 8 * (p & 7); vl[i] = KT_BYTES + (p >> 3) * VROW + (p & 7) * 16; }
    u32x4 kr[2], vr[2];
#pragma unroll
    for (int i = 0; i < 2; ++i) { kr[i] = *(const u32x4*)(kg[i] + (size_t)(nkt - 1) * 64 * NP); vr[i] = *(const u32x4*)(vg[i] + (nkt - 1) * 64); }
    f32x4 creg = (f32x4){0.f, 0.f, 0.f, 0.f};
    if (TYPE == 1 && tid < 16) creg = *(const f32x4*)(cb + (nkt - 1) * 64 + 4 * tid);
    LAS float* flags = (LAS float*)(lds + FLAG_OFF);
    for (int it = 0; it < nkt; ++it) {
        const int kt = nkt - 1 - it; LAS unsigned char* buf = lds + (it & 1) * BUF;
#pragma unroll
        for (int i = 0; i < 2; ++i) { *(LAS u32x4*)(buf + kl[i]) = kr[i]; *(LAS u32x2*)(buf + vl[i]) = (u32x2){vr[i].x, vr[i].y}; *(LAS u32x2*)(buf + vl[i] + 8) = (u32x2){vr[i].z, vr[i].w}; }
        if (TYPE == 1 && tid < 16) *(LAS f32x4*)(buf + C_OFF + 16 * tid) = creg;
        if (kt > 0) {
#pragma unroll
            for (int i = 0; i < 2; ++i) { kr[i] = *(const u32x4*)(kg[i] + (size_t)(kt - 1) * 64 * NP); vr[i] = *(const u32x4*)(vg[i] + (kt - 1) * 64); }
            if (TYPE == 1 && tid < 16) creg = *(const f32x4*)(cb + (kt - 1) * 64 + 4 * tid);
        }
        __syncthreads();
        if (it > 0) {
            float mx = flags[((it - 1) & 1) * 8];
#pragma unroll
            for (int j = 1; j < 8; ++j) mx = fmaxf(mx, flags[((it - 1) & 1) * 8 + j]);
            if (mx < -40.f) break;
        }
        if (64 * kt <= qw0 + 31) {
            f32x16 s[2];
#pragma unroll
            for (int kb = 0; kb < 2; ++kb) {
#pragma unroll
                for (int i = 0; i < 16; ++i) s[kb][i] = 0.f;
#pragma unroll
                for (int ks = 0; ks < 8; ++ks) { const bf16x8 a = *(const LAS bf16x8*)(buf + (32 * kb + q) * KROW + (16 * ks + 8 * hi) * 2);
                    s[kb] = __builtin_amdgcn_mfma_f32_32x32x16_bf16(a, qf[ks], s[kb], 0, 0, 0); }
            }
            const bool need_mask = (64 * kt + 63 >= qw0);
            bf16x8 pf[4];
            if (TYPE == 1) {
                float mloc = -INFINITY;
#pragma unroll
                for (int kb = 0; kb < 2; ++kb)
#pragma unroll
                    for (int g4 = 0; g4 < 4; ++g4) { const int sb = 64 * kt + 32 * kb + 8 * g4 + 4 * hi; const f32x4 c4 = *(const LAS f32x4*)(buf + C_OFF + (32 * kb + 8 * g4 + 4 * hi) * 4);
#pragma unroll
                        for (int e = 0; e < 4; ++e) { float z = s[kb][4 * g4 + e] * SCALE - c4[e]; if (need_mask && (sb + e > tq)) z = -INFINITY; s[kb][4 * g4 + e] = z; mloc = fmaxf(mloc, z); } }
                mloc = fmaxf(mloc, __shfl_xor(mloc, 32));
                const float m_new = fmaxf(m_run, mloc), alpha = __expf(m_run - m_new);
                float ls = 0.f;
#pragma unroll
                for (int kb = 0; kb < 2; ++kb)
#pragma unroll
                    for (int i = 0; i < 16; ++i) { const float pe = __expf(s[kb][i] - m_new); s[kb][i] = pe; ls += pe; }
                l_run = l_run * alpha + ls; m_run = m_new;
#pragma unroll
                for (int d = 0; d < 4; ++d)
#pragma unroll
                    for (int i = 0; i < 16; ++i) o[d][i] *= alpha;
            } else {
                float lr[2][16], gs[8], par[8];
#pragma unroll
                for (int kb = 0; kb < 2; ++kb)
#pragma unroll
                    for (int g4 = 0; g4 < 4; ++g4) { const int sb = 64 * kt + 32 * kb + 8 * g4 + 4 * hi; float sum = 0.f;
#pragma unroll
                        for (int e = 0; e < 4; ++e) { const float z = s[kb][4 * g4 + e] * SCALE; const float sp = __logf(1.f + __expf(-fabsf(z)));
                            const float lb = fminf(z, 0.f) - sp; const bool valid = !(need_mask && (sb + e >= tq));
                            const float l_ = valid ? (lb - z) : 0.f; lr[kb][4 * g4 + e] = l_; sum += l_;
                            s[kb][4 * g4 + e] = valid ? lb : -INFINITY; }
                        gs[4 * kb + g4] = sum; }
#pragma unroll
                for (int L = 0; L < 8; ++L) par[L] = __shfl_xor(gs[L], 32);
                float accO = 0.f, accP = 0.f;
#pragma unroll
                for (int L = 7; L >= 0; --L) { const int kb = L >> 2, g4 = L & 3;
                    float run = R + accO + accP + (hi == 0 ? par[L] : 0.f);
#pragma unroll
                    for (int e = 3; e >= 0; --e) { const float lb = s[kb][4 * g4 + e]; s[kb][4 * g4 + e] = __expf(lb + run); run += lr[kb][4 * g4 + e]; }
                    accO += gs[L]; accP += par[L]; }
                R += accO + accP;
            }
#pragma unroll
            for (int j = 0; j < 4; ++j) { const int kb = j >> 1, ib = 8 * (j & 1);
                u32x4 w; w.x = cvt_pk_bf16(s[kb][ib + 0], s[kb][ib + 1]); w.y = cvt_pk_bf16(s[kb][ib + 2], s[kb][ib + 3]); w.z = cvt_pk_bf16(s[kb][ib + 4], s[kb][ib + 5]); w.w = cvt_pk_bf16(s[kb][ib + 6], s[kb][ib + 7]);
                pf[j] = __builtin_bit_cast(bf16x8, w); }
#pragma unroll
            for (int d = 0; d < 4; ++d)
#pragma unroll
                for (int j = 0; j < 4; ++j) { const LAS unsigned char* vp = buf + KT_BYTES + (32 * d + q) * VROW + (16 * j + 4 * hi) * 2;
                    const u32x2 v0 = *(const LAS u32x2*)vp, v1 = *(const LAS u32x2*)(vp + 16);
                    const bf16x8 a = __builtin_bit_cast(bf16x8, (u32x4){v0.x, v0.y, v1.x, v1.y});
                    o[d] = __builtin_amdgcn_mfma_f32_32x32x16_bf16(a, pf[j], o[d], 0, 0, 0); }
        }
        { float rm = R;
            if (TYPE == 1) rm = zb - *(const LAS float*)(buf + C_OFF) - m_run;
#pragma unroll
            for (int o_ = 1; o_ < 32; o_ <<= 1) rm = fmaxf(rm, __shfl_xor(rm, o_));
            if (lane == 0) flags[(it & 1) * 8 + w] = rm; }
    }
    if (TYPE == 1) { const float lt = l_run + __shfl_xor(l_run, 32); const float inv = 1.0f / lt;
#pragma unroll
        for (int d = 0; d < 4; ++d)
#pragma unroll
            for (int i = 0; i < 16; ++i) o[d][i] *= inv; }
    bf16_t* yp = Y + (rowbase + tq) * 1024 + (TYPE == 0 ? 0 : 512) + h * 128 + 4 * hi;
#pragma unroll
    for (int d = 0; d < 4; ++d)
#pragma unroll
        for (int g4 = 0; g4 < 4; ++g4) { u32x2 w; w.x = cvt_pk_bf16(o[d][4 * g4], o[d][4 * g4 + 1]); w.y = cvt_pk_bf16(o[d][4 * g4 + 2], o[d][4 * g4 + 3]); *(u32x2*)(yp + 32 * d + 8 * g4) = w; }
    __syncthreads();
}
}

namespace rwkv {
typedef float f32x2 __attribute__((ext_vector_type(2)));
struct ChunkRegs { u32x4 zr, zk, zv, pr, pk, pv, e8, a8; };
constexpr int CH = 32;
constexpr int BUFF = 11392;
__device__ __forceinline__ void load_chunk(ChunkRegs& c, const bf16_t* PROJ, const bf16_t* LO, int b, int ci, int pt, int col) {
    const int s = ci * CH + pt; const size_t T = (size_t)b * SEQ + s;
    const bf16_t* rp = PROJ + T * NP + C_RW + col;
    c.zr = *(const u32x4*)rp; c.zk = *(const u32x4*)(rp + 1024); c.zv = *(const u32x4*)(rp + 2048);
    if (s > 0) { c.pr = *(const u32x4*)(rp - NP); c.pk = *(const u32x4*)(rp - NP + 1024); c.pv = *(const u32x4*)(rp - NP + 2048); }
    else { c.pr = (u32x4){0u, 0u, 0u, 0u}; c.pk = c.pr; c.pv = c.pr; }
    const bf16_t* lp = LO + T * NLORA + col;
    c.e8 = *(const u32x4*)lp; c.a8 = *(const u32x4*)(lp + 1024);
}
__device__ __forceinline__ void prep_chunk(const ChunkRegs& cr, LAS float* bufp, const LAS float* par, int pt, int pc, int qv, float* bonp) {
    float zr[8], zk[8], zv[8], qr[8], qk[8], qv_[8], e8[8], a8[8];
    unpack8(cr.zr, zr); unpack8(cr.zk, zk); unpack8(cr.zv, zv); unpack8(cr.pr, qr); unpack8(cr.pk, qk); unpack8(cr.pv, qv_); unpack8(cr.e8, e8); unpack8(cr.a8, a8);
    float kkr[8], kp[8], wv[8], rr[8], vv[8]; float n2 = 0.f;
#pragma unroll
    for (int e = 0; e < 8; ++e) {
        const float r = zr[e] + (qr[e] - zr[e]) * par[0 * 64 + pc + e];
        const float k = zk[e] + (qk[e] - zk[e]) * par[1 * 64 + pc + e];
        const float v = zv[e] + (qv_[e] - zv[e]) * par[2 * 64 + pc + e];
        wv[e] = __expf(e8[e]);
        rr[e] = r; vv[e] = v; kkr[e] = k * par[3 * 64 + pc + e]; n2 += kkr[e] * kkr[e];
        kp[e] = k * (1.f + (a8[e] - 1.f) * par[4 * 64 + pc + e]);
    }
    n2 = sum8(n2);
    const float inv = fminf(__builtin_amdgcn_rsqf(n2), 1e12f);
    float kr = 0.f, kkar = 0.f, bon = 0.f;
    float kk[8], kka[8], wr[8];
#pragma unroll
    for (int e = 0; e < 8; ++e) { kk[e] = kkr[e] * inv; kka[e] = kk[e] * a8[e]; wr[e] = wv[e] * rr[e];
        kr += kp[e] * rr[e]; kkar += kka[e] * rr[e]; bon += rr[e] * kp[e] * par[5 * 64 + pc + e]; }
    kr = sum8(kr); kkar = sum8(kkar); bon = sum8(bon);
    const int o = pt * 64 + pc;
    *(LAS f32x4*)(bufp + o) = (f32x4){kk[0], kk[1], kk[2], kk[3]}; *(LAS f32x4*)(bufp + o + 4) = (f32x4){kk[4], kk[5], kk[6], kk[7]};
    *(LAS f32x4*)(bufp + 2048 + o) = (f32x4){wr[0], wr[1], wr[2], wr[3]}; *(LAS f32x4*)(bufp + 2048 + o + 4) = (f32x4){wr[4], wr[5], wr[6], wr[7]};
    *(LAS f32x4*)(bufp + 4096 + o) = (f32x4){wv[0], wv[1], wv[2], wv[3]}; *(LAS f32x4*)(bufp + 4096 + o + 4) = (f32x4){wv[4], wv[5], wv[6], wv[7]};
    *(LAS f32x4*)(bufp + 6144 + o) = (f32x4){kp[0], kp[1], kp[2], kp[3]}; *(LAS f32x4*)(bufp + 6144 + o + 4) = (f32x4){kp[4], kp[5], kp[6], kp[7]};
    *(LAS f32x4*)(bufp + 8192 + o) = (f32x4){kka[0], kka[1], kka[2], kka[3]}; *(LAS f32x4*)(bufp + 8192 + o + 4) = (f32x4){kka[4], kka[5], kka[6], kka[7]};
    if ((pc >> 5) == qv) { LAS float* vp = bufp + 10240 + pt * 32 + (pc & 24);
        *(LAS f32x4*)vp = (f32x4){vv[0], vv[1], vv[2], vv[3]}; *(LAS f32x4*)(vp + 4) = (f32x4){vv[4], vv[5], vv[6], vv[7]}; }
    if (pc == 0) { *(LAS f32x2*)(bufp + 11264 + 2 * pt) = (f32x2){kr, kkar}; if (qv == 0) *bonp = bon; }
}
__device__ __forceinline__ void rwkv_item(LAS unsigned char* lds, int l, const bf16_t* PROJ, const bf16_t* LO, bf16_t* YR, float* BON, int b, int h, int qv) {
    LAS float* base = (LAS float*)lds; LAS float* yA = base + 2 * BUFF; LAS float* par = yA + 8192;
    int tid_ = threadIdx.x; asm volatile("" : "+v"(tid_));
    const int tid = tid_, w = __builtin_amdgcn_readfirstlane(tid >> 6), lane = tid & 63;
    {
        const int a = tid >> 6, ch = tid & 63, c = h * 64 + ch; float v;
        if (a == 0) v = arg_in(7)[(size_t)l * 3360 + c]; else if (a == 1) v = arg_in(7)[(size_t)l * 3360 + 1024 + c]; else if (a == 2) v = arg_in(7)[(size_t)l * 3360 + 2048 + c];
        else if (a == 3) v = arg_in(13)[(size_t)l * 1024 + c]; else if (a == 4) v = arg_in(14)[(size_t)l * 1024 + c]; else if (a == 5) v = arg_in(15)[(size_t)l * 1024 + c];
        else if (a == 6) v = arg_in(8)[(size_t)l * 1024 + c]; else v = arg_in(10)[(size_t)l * 1024 + c];
        par[a * 64 + ch] = v;
    }
    __syncthreads();
    constexpr int NCH = SEQ / CH;
    if (w >= 4) {
        const int ptid = tid & 255, pt = ptid >> 3, pc = (ptid & 7) * 8, col = h * 64 + pc;
        float* bonb = BON + ((size_t)b * SEQ + pt) * 16 + h;
        ChunkRegs cr, nx; load_chunk(cr, PROJ, LO, b, 0, pt, col);
        prep_chunk(cr, base, par, pt, pc, qv, bonb);
        load_chunk(cr, PROJ, LO, b, 1, pt, col);
        __syncthreads();
        for (int ci = 0; ci < NCH; ++ci) {
            if (ci + 2 < NCH) load_chunk(nx, PROJ, LO, b, ci + 2, pt, col); else nx = cr;
            if (ci >= 1 && ptid < 128) { const int t = ptid >> 2, q4 = ptid & 3; const LAS float* yp = yA + ((ci - 1) & 1) * 4096 + (t * 32 + 8 * q4) * 4;
                float yv[8];
#pragma unroll
                for (int r = 0; r < 8; ++r) { const f32x4 q = *(const LAS f32x4*)(yp + 4 * r); yv[r] = (q[0] + q[1]) + (q[2] + q[3]); }
                *(u32x4*)(YR + ((size_t)b * SEQ + (ci - 1) * CH + t) * 1024 + h * 64 + 32 * qv + 8 * q4) = pack8(yv); }
            if (ci + 1 < NCH) prep_chunk(cr, base + ((ci + 1) & 1) * BUFF, par, pt, pc, qv, bonb + (size_t)(ci + 1) * CH * 16);
            cr = nx;
            __syncthreads();
        }
        if (ptid < 128) { const int t = ptid >> 2, q4 = ptid & 3; const LAS float* yp = yA + ((NCH - 1) & 1) * 4096 + (t * 32 + 8 * q4) * 4;
            float yv[8];
#pragma unroll
            for (int r = 0; r < 8; ++r) { const f32x4 q = *(const LAS f32x4*)(yp + 4 * r); yv[r] = (q[0] + q[1]) + (q[2] + q[3]); }
            *(u32x4*)(YR + ((size_t)b * SEQ + (NCH - 1) * CH + t) * 1024 + h * 64 + 32 * qv + 8 * q4) = pack8(yv); }
    } else {
        __builtin_amdgcn_s_setprio(3);
        const int rl = 8 * w + (lane >> 4), kq = lane & 15;
        f32x2 S01[2], S23[2];
#pragma unroll
        for (int c = 0; c < 2; ++c) { S01[c] = (f32x2){0.f, 0.f}; S23[c] = (f32x2){0.f, 0.f}; }
        __syncthreads();
        for (int ci = 0; ci < NCH; ++ci) {
            const LAS float* pk = base + (ci & 1) * BUFF + 4 * kq; const LAS float* pv = base + (ci & 1) * BUFF + 10240 + rl; const LAS float* ps = base + (ci & 1) * BUFF + 11264;
            LAS float* py = yA + (ci & 1) * 4096 + rl * 4 + (kq >> 2);
            f32x4 kk4 = *(const LAS f32x4*)(pk), wr4 = *(const LAS f32x4*)(pk + 2048), w4 = *(const LAS f32x4*)(pk + 4096), k4 = *(const LAS f32x4*)(pk + 6144), a4 = *(const LAS f32x4*)(pk + 8192);
            float vv[2] = {pv[0], pv[4]}; f32x2 sc = *(const LAS f32x2*)(ps);
#pragma unroll 32
            for (int t = 0; t < CH; ++t) {
                const int tn = (t + 1) & (CH - 1);
                const LAS float* pn = pk + tn * 64;
                const f32x4 nkk = *(const LAS f32x4*)(pn), nwr = *(const LAS f32x4*)(pn + 2048), nw = *(const LAS f32x4*)(pn + 4096), nk = *(const LAS f32x4*)(pn + 6144), na = *(const LAS f32x4*)(pn + 8192);
                const float nv0 = pv[tn * 32], nv1 = pv[tn * 32 + 4]; const f32x2 nsc = *(const LAS f32x2*)(ps + 2 * tn);
                float sa[2], yp[2];
#pragma unroll
                for (int c = 0; c < 2; ++c) { const f32x2 pa = S23[c] * kk4.hi + S01[c] * kk4.lo, pb = S23[c] * wr4.hi + S01[c] * wr4.lo; sa[c] = pa.x + pa.y; yp[c] = pb.x + pb.y; }
#pragma unroll
                for (int c = 0; c < 2; ++c) { sa[c] = sum16(sa[c]); yp[c] += dppf<0xB1>(yp[c]); yp[c] += dppf<0x4E>(yp[c]); }
#pragma unroll
                for (int c = 0; c < 2; ++c) {
                    S01[c] = S01[c] * w4.lo + (k4.lo * vv[c] - a4.lo * sa[c]);
                    S23[c] = S23[c] * w4.hi + (k4.hi * vv[c] - a4.hi * sa[c]);
                    py[(t * 32 + 4 * c) * 4] = yp[c] + 0.25f * (vv[c] * sc.x - sa[c] * sc.y);
                }
                kk4 = nkk; wr4 = nwr; w4 = nw; k4 = nk; a4 = na; vv[0] = nv0; vv[1] = nv1; sc = nsc;
            }
            __syncthreads();
        }
        __builtin_amdgcn_s_setprio(0);
    }
    __syncthreads();
}
__device__ __forceinline__ void rwkv_post(int l, const bf16_t* PROJ, const bf16_t* LO, bf16_t* YR, const float* BON, int gtid, int nthr) {
    const float* mu = arg_in(7) + (size_t)l * 3360 + 2048; const float* lnw = arg_in(16) + (size_t)l * 1024; const float* lnb = arg_in(17) + (size_t)l * 1024;
    for (int it = gtid; it < TT * 128; it += nthr) {
        const int T = it >> 7, cgp = it & 127, c0 = 8 * cgp, h = cgp >> 3;
        float yv[8], zc[8], zp[8], gg[8];
        unpack8(*(const u32x4*)(YR + (size_t)T * 1024 + c0), yv);
        const bf16_t* vp = PROJ + (size_t)T * NP + C_RW + 2048 + c0;
        unpack8(*(const u32x4*)vp, zc);
        if ((T & (SEQ - 1)) != 0) unpack8(*(const u32x4*)(vp - NP), zp); else {
#pragma unroll
            for (int e = 0; e < 8; ++e) zp[e] = 0.f; }
        unpack8(*(const u32x4*)(LO + (size_t)T * NLORA + 2048 + c0), gg);
        float sm = 0.f;
#pragma unroll
        for (int e = 0; e < 8; ++e) sm += yv[e];
        const float mean = sum8(sm) * (1.0f / 64.0f);
        float sq = 0.f;
#pragma unroll
        for (int e = 0; e < 8; ++e) { const float d = yv[e] - mean; sq += d * d; }
        const float rstd = rsqrtf(sum8(sq) * (1.0f / 64.0f) + GN_EPS);
        const float bon = BON[(size_t)T * 16 + h];
        const f32x4 m0 = *(const f32x4*)(mu + c0), m1 = *(const f32x4*)(mu + c0 + 4), w0 = *(const f32x4*)(lnw + c0), w1 = *(const f32x4*)(lnw + c0 + 4), b0 = *(const f32x4*)(lnb + c0), b1 = *(const f32x4*)(lnb + c0 + 4);
        float out[8];
#pragma unroll
        for (int e = 0; e < 8; ++e) { const float mm = e < 4 ? m0[e] : m1[e - 4], ww = e < 4 ? w0[e] : w1[e - 4], bb = e < 4 ? b0[e] : b1[e - 4];
            const float v = zc[e] + (zp[e] - zc[e]) * mm; out[e] = ((yv[e] - mean) * rstd * ww + bb + bon * v) * gg[e]; }
        *(u32x4*)(YR + (size_t)T * 1024 + c0) = pack8(out);
    }
}
}


#define XB_TMO      128
#define XB_XCNT(j)  (256  + 64 * (j))
#define XB_XSUB(j)  (1280 + 64 * (j))
#define XB_XGEN(j)  (2304 + 64 * (j))
#define XB_TOP      3328
#define XB_TOPGEN   3392
#define XCD_BAR_WORDS 3456
#define XB_SPIN_CAP (1u << 22)
__device__ __forceinline__ unsigned xb_ld(unsigned* p)              { return __hip_atomic_load(p, __ATOMIC_RELAXED, __HIP_MEMORY_SCOPE_AGENT); }
__device__ __forceinline__ unsigned xb_add(unsigned* p, unsigned v) { return __hip_atomic_fetch_add(p, v, __ATOMIC_RELAXED, __HIP_MEMORY_SCOPE_AGENT); }
__device__ __forceinline__ unsigned xb_xcc_id() { return (unsigned)__builtin_amdgcn_s_getreg((3 << 11) | 20) & 0xFu; }
#define XB_SPIN(cond, bar) do { unsigned _sp = 0; while (cond) { __builtin_amdgcn_s_sleep(1); \
    if ((++_sp & 255u) == 0u) { if (xb_ld(&(bar)[XB_TMO])) break; if (_sp > XB_SPIN_CAP) { atomicAdd(&(bar)[XB_TMO], 1u); break; } } } } while (0)
struct XcdBarrier { unsigned* bar; unsigned x; volatile LAS unsigned* st; };
__device__ __forceinline__ XcdBarrier xcd_barrier_post(unsigned* bar, volatile LAS unsigned* st) {
    XcdBarrier b; b.bar = bar; b.x = xb_xcc_id(); b.st = st;
    if (threadIdx.x == 0) (void)xb_add(&bar[XB_XCNT(b.x)], 1u);
    return b;
}
__device__ __forceinline__ void xcd_barrier_complete(unsigned* bar, unsigned x, unsigned& nloc, unsigned& nx) {
    const unsigned G = gridDim.x * gridDim.y * gridDim.z;
    unsigned sum, cnt, mine, sp = 0u;
    for (;;) {
        sum = 0u; cnt = 0u; mine = 0u;
#pragma unroll
        for (unsigned j = 0; j < 16; ++j) { const unsigned c = xb_ld(&bar[XB_XCNT(j)]); sum += c; cnt += (c > 0u) ? 1u : 0u; mine = (j == x) ? c : mine; }
        if (sum == G) break;
        __builtin_amdgcn_s_sleep(1);
        if ((++sp & 255u) == 0u) { if (xb_ld(&bar[XB_TMO])) break; if (sp > XB_SPIN_CAP) { atomicAdd(&bar[XB_TMO], 1u); break; } }
    }
    nloc = mine > 0u ? mine : 1u; nx = cnt > 0u ? cnt : 1u;
}
__device__ __forceinline__ void xcd_barrier(const XcdBarrier& b) {
    asm volatile("s_waitcnt vmcnt(0)" ::: "memory");
    __syncthreads();
    if (threadIdx.x == 0) {
        unsigned* bar = b.bar;
        __builtin_amdgcn_s_waitcnt(0);
        unsigned nloc = b.st[0], nx = b.st[1];
        if (nloc == 0u) { xcd_barrier_complete(bar, b.x, nloc, nx); b.st[0] = nloc; b.st[1] = nx; }
        const unsigned old = xb_add(&bar[XB_XSUB(b.x)], 1u);
        const unsigned gen = old / nloc;
        if (old + 1u == (gen + 1u) * nloc) {
            __builtin_amdgcn_fence(__ATOMIC_RELEASE, "agent");
            asm volatile("s_waitcnt vmcnt(0)" ::: "memory");
            const unsigned og = xb_add(&bar[XB_TOP], 1u);
            const unsigned tg = og / nx;
            if (og + 1u == (tg + 1u) * nx) xb_add(&bar[XB_TOPGEN], 1u);
            else XB_SPIN(xb_ld(&bar[XB_TOPGEN]) == tg, bar);
            __builtin_amdgcn_fence(__ATOMIC_ACQUIRE, "agent");
            xb_add(&bar[XB_XGEN(b.x)], 1u);
            asm volatile("s_waitcnt vmcnt(0)" ::: "memory");
        } else {
            XB_SPIN(xb_ld(&bar[XB_XGEN(b.x)]) == gen, bar);
            __builtin_amdgcn_fence(__ATOMIC_ACQUIRE, "agent");
            asm volatile("s_waitcnt vmcnt(0)" ::: "memory");
        }
    }
    __syncthreads();
}

#ifndef PHASEMASK
#define PHASEMASK 63
#endif
#ifndef DUP_RWKV
#define DUP_RWKV 1
#endif
#ifndef DUP_ATT
#define DUP_ATT 1
#endif
#ifndef DUP_SYNC
#define DUP_SYNC 0
#endif
template <class T> __device__ __forceinline__ T* launder(T* q) { asm volatile("" : "+s"(q)); return q; }
#define WSP(off) ((bf16_t*)(arg_ws() + (off)))
__global__ void __launch_bounds__(512, 2) mega_fwd(Params p) {
    extern __shared__ __attribute__((aligned(16))) unsigned char lds_raw[];
    LAS unsigned char* lds = (LAS unsigned char*)lds_raw;
    cg::grid_group grid = cg::this_grid();
    const int G = gridDim.x, bid = blockIdx.x;
    volatile LAS unsigned* bst = (volatile LAS unsigned*)(lds + LDS_BYTES - 64);
    if (threadIdx.x < 2) bst[threadIdx.x] = 0u;
    __syncthreads();
    XcdBarrier xbar = xcd_barrier_post((unsigned*)arg_ws(), bst);
#define GSYNC() xcd_barrier(xbar)
#define TIDS int tid_ = threadIdx.x; asm volatile("" : "+v"(tid_)); const int tid = tid_, lane = tid & 63, wave = __builtin_amdgcn_readfirstlane(tid >> 6), gw = bid * 8 + wave, ngw = G * 8, gtid = bid * 512 + tid, nthr = G * 512; (void)lane; (void)gw; (void)ngw; (void)gtid; (void)nthr;

    { TIDS convert_weights(p, 0, lds, gw, ngw, wave, lane, gtid, nthr);
      norm_rows<false>(arg_in(0), nullptr, nullptr, nullptr, arg_in(1), WSP(WS_U), gw, ngw, lane); }
    grid.sync();
#pragma unroll 1
    for (int l = 0; l < 2; ++l) {
#if PHASEMASK & 1
        { pg8::Gemm g{WSP(WS_U), WSP(WS_WIN), TT, C_GATE, DM, DM, 0}; pg8::StaticOrder S; S.init(TT, C_GATE, G, bid);
          pg8::EpiStore<pg8::FProj> E{WSP(WS_BIG), NP, pg8::FProj{1 << 30}}; pg8::gemm_phase(lds, g, S, E); }
        { pg8::Gemm g{WSP(WS_WIN) + (size_t)NP * DM, WSP(WS_U), 1024, TT, DM, DM, 0}; pg8::StaticOrder S; S.init(1024, TT, G, bid);
          pg8::EpiStore<pg8::FProj> E{WSP(WS_VT), TT, pg8::FProj{1 << 30}}; pg8::gemm_phase(lds, g, S, E); }
        { pg8::Gemm g{WSP(WS_U), WSP(WS_WIN) + (size_t)C_GATE * DM, TT, GATE1, DM, DM, 0}; pg8::StaticOrder S; S.init(TT, GATE1, G, (bid + (G >> 1)) % G);
          pg8::EpiStore<pg8::FProj> E{WSP(WS_BIG) + C_GATE, NP, pg8::FProj{0}}; pg8::gemm_phase(lds, g, S, E); }
#endif
        GSYNC();
        { TIDS
          fox_cumsum(WSP(WS_BIG), arg_in(6) + (size_t)l * 4, (float*)WSP(WS_C), lds, bid, G, tid);
          lora_prep(WSP(WS_BIG), arg_in(7) + (size_t)l * 3360, WSP(WS_LA), gtid, nthr);
          fox_kmax(WSP(WS_BIG), (unsigned*)arg_ws() + 8192 + l * 16, gw, ngw, lane); }
        GSYNC();
#if PHASEMASK & 2
        { pg8::Gemm g{WSP(WS_LA), WSP(WS_WLORA), TT, NLORA, KLORA, KLORA, 0}; pg8::StaticOrder S; S.init(TT, NLORA, G, bid);
          pg8::EpiStore<pg8::FLora> E{WSP(WS_LO), NLORA, pg8::FLora{arg_in(8) + (size_t)l * 1024, arg_in(10) + (size_t)l * 1024}}; pg8::gemm_phase(lds, g, S, E); }
#endif
        GSYNC();
        {
            const int ra = G >> 1, na = G - ra;
#ifndef NO_RWKV
            if (bid < ra) for (int it = bid; it < 128; it += ra) rwkv::rwkv_item(lds, l, WSP(WS_BIG), WSP(WS_LO), WSP(WS_YR), (float*)WSP(WS_BON), it >> 5, (it >> 1) & 15, it & 1);
#endif
            if (bid >= ra) {
#ifndef NO_ATT
                for (int it = bid - ra; it < 512; it += na) {
                    if (it < 256) { const int qb = 15 - (it >> 4), bh = it & 15; att::attn_item<1>(lds, WSP(WS_BIG), WSP(WS_VT), (const float*)WSP(WS_C) + (size_t)bh * SEQ, __uint_as_float(((const unsigned*)arg_ws())[8192 + l * 16 + bh]), WSP(WS_YAB), bh >> 2, bh & 3, qb); }
                    else { const int j = it - 256; const int qb = 15 - (j >> 4), bh = j & 15; att::attn_item<0>(lds, WSP(WS_BIG), WSP(WS_VT), nullptr, 0.f, WSP(WS_YAB), bh >> 2, bh & 3, qb); }
                }
#endif
                { pg8::Gemm g{WSP(WS_U), WSP(WS_WIN) + (size_t)(C_GATE + GATE1) * DM, TT, GATE2, DM, DM, 0}; pg8::StaticOrder S; S.init(TT, GATE2, na, bid - ra);
                  pg8::EpiStore<pg8::FProj> E{WSP(WS_BIG) + C_GATE + GATE1, NP, pg8::FProj{0}}; pg8::gemm_phase(lds, g, S, E); }
            }
        }
        GSYNC();
        for (int rep = 0; rep < DUP_SYNC; ++rep) GSYNC();
        { TIDS rwkv::rwkv_post(l, WSP(WS_BIG), WSP(WS_LO), WSP(WS_YR), (const float*)WSP(WS_BON), gtid, nthr); }
        GSYNC();
#if PHASEMASK & 4
        { pg8::Gemm g{WSP(WS_YAB), WSP(WS_WBR), TT, DM, DM, 1024, (long)((long)WS_YR - (long)WS_YAB) - 2048L}; pg8::StaticOrder S; S.init(TT, DM, G, bid);
          pg8::EpiBranch E{WSP(WS_LO), WSP(WS_BIG) + C_GATE}; pg8::gemm_phase(lds, g, S, E); }
#endif
        GSYNC();
#if PHASEMASK & 8
        { pg8::Gemm g{WSP(WS_LO), WSP(WS_WOUT), TT, DM, DM, DM, 0}; pg8::StaticOrder S; S.init(TT, DM, G, bid);
          pg8::EpiStore<pg8::FId> E{WSP(WS_TMP), DM, pg8::FId{}}; pg8::gemm_phase(lds, g, S, E); }
#endif
        GSYNC();
        { TIDS const float* xin = (l == 0) ? arg_in(0) : (const float*)arg_out();
          norm_rows<true>(xin, WSP(WS_TMP), arg_in(2) + (size_t)l * DM, arg_out(), arg_in(3) + (size_t)l * DM, WSP(WS_U), gw, ngw, lane); }
        GSYNC();
#if PHASEMASK & 16
        { pg8::Gemm g{WSP(WS_U), WSP(WS_WUP), TT, FF, DM, DM, 0}; pg8::StaticOrder S; S.init(TT, FF, G, bid);
          pg8::EpiStore<pg8::FRelu2> E{WSP(WS_BIG), FF, pg8::FRelu2{}}; pg8::gemm_phase(lds, g, S, E); }
#endif
        GSYNC();
#if PHASEMASK & 32
        { pg8::Gemm g{WSP(WS_BIG), WSP(WS_WDN), TT, DM, FF, FF, 0}; pg8::StaticOrder S; S.init(TT, DM, G, bid);
          pg8::EpiStore<pg8::FId> E{WSP(WS_TMP), DM, pg8::FId{}}; pg8::gemm_phase(lds, g, S, E); }
#endif
        GSYNC();
        { TIDS norm_rows<true>(arg_out(), WSP(WS_TMP), arg_in(4) + (size_t)l * DM, arg_out(), (l == 0) ? arg_in(1) + DM : (const float*)nullptr, WSP(WS_U), gw, ngw, lane);
          if (l == 0) convert_weights(p, 1, lds, gw, ngw, wave, lane, gtid, nthr); }
        if (l == 0) GSYNC();
    }
}

extern "C" void kernel_launch(void* const* d_in, const int* in_sizes, int n_in, void* d_out, int out_size, void* d_ws, size_t ws_size, hipStream_t stream) {
    static int grid_blocks = 0;
    if (grid_blocks == 0) {
        if (n_in != 24 || ws_size < WS_END) { fprintf(stderr, "kernel_launch: unexpected n_in %d / ws %zu\n", n_in, ws_size); grid_blocks = -1; return; }
        int dev = 0, cus = 0, per_cu = 0;
        hipGetDevice(&dev);
        hipDeviceGetAttribute(&cus, hipDeviceAttributeMultiprocessorCount, dev);
        hipFuncSetAttribute((const void*)mega_fwd, hipFuncAttributeMaxDynamicSharedMemorySize, LDS_BYTES);
        hipOccupancyMaxActiveBlocksPerMultiprocessor(&per_cu, (const void*)mega_fwd, 512, LDS_BYTES);
        if (per_cu < 1) per_cu = 1;
        grid_blocks = cus * per_cu;
        (void)hipGetLastError();
    }
    if (grid_blocks < 0) return;
    if (hipMemsetAsync(d_ws, 0, 65536, stream) != hipSuccess) { fprintf(stderr, "memset failed\n"); return; }
    Params p{};
    for (int i = 0; i < 24; ++i) p.in[i] = (const float*)d_in[i];
    p.out = (float*)d_out; p.ws = (unsigned char*)d_ws;
    void* args[] = {&p};
    hipError_t e = hipLaunchCooperativeKernel((const void*)mega_fwd, dim3(grid_blocks), dim3(512), args, LDS_BYTES, stream);
    if (e != hipSuccess) fprintf(stderr, "cooperative launch failed: %s (grid %d)\n", hipGetErrorString(e), grid_blocks);
}
```
